# Optimizing an MI355X kernel written in HIP

```python
import jax, jax.numpy as jnp
from jax import lax
import numpy as np

D_MODEL = 2048
BATCH = 8
SEQ = 2048
DEPTH = 2

CONV_CH = 1024
CONV_K = 3
N_HEADS = 8
HEAD_DIM = 128
N_KV_HEADS = 2
GQA_GROUP = N_HEADS // N_KV_HEADS
ATTN_WIDTH = N_HEADS * HEAD_DIM
KV_WIDTH = N_KV_HEADS * HEAD_DIM
IDX_HEADS = 16
IDX_DIM = 64
TOPK_MAX = 256
Q_BLOCK = 128
N_BRANCHES = 2
IN_WIDTHS = (CONV_CH, CONV_CH, CONV_CH,
             ATTN_WIDTH, KV_WIDTH, KV_WIDTH,
             IDX_HEADS * IDX_DIM, IDX_DIM, IDX_HEADS,
             N_BRANCHES * D_MODEL)
IN_COLS = sum(IN_WIDTHS)
D_FF = 5632
N_EXPERTS = 8
TOP_K_EXPERTS = 2
D_FF_EXPERT = 7168
MOE_BLOCK = 256
N_MOE_LAYERS = DEPTH // 2
N_DENSE_LAYERS = DEPTH - N_MOE_LAYERS
RMS_EPS = 1e-6

kernel_name = "hybrid_conv_dsa_gated_moe_block"


def rmsnorm(x, g):
    xf = x.astype(jnp.float32)
    y = xf * lax.rsqrt(jnp.mean(xf * xf, axis=-1, keepdims=True) + RMS_EPS)
    return (y * g.astype(jnp.float32)).astype(x.dtype)


def split_columns(proj):
    offsets = []
    acc = 0
    for w in IN_WIDTHS[:-1]:
        acc += w
        offsets.append(acc)
    return jnp.split(proj, offsets, axis=-1)


def short_conv_mixer(b_gate, c_gate, u, conv_w):
    v = c_gate * u
    rhs = conv_w.astype(v.dtype)[:, None, :]
    y = lax.conv_general_dilated(v, rhs, window_strides=(1,), padding=[(CONV_K - 1, 0)],
                                 dimension_numbers=('NWC', 'WIO', 'NWC'),
                                 feature_group_count=v.shape[-1])
    return b_gate * y


def dsa_attention(q, k, v, q_idx, k_idx, w_idx):
    bsz, seq = q.shape[0], q.shape[1]
    topk = min(TOPK_MAX, seq // 4)
    n_blk = seq // Q_BLOCK
    key_pos = jnp.arange(seq)

    def to_blocks(a):
        return jnp.moveaxis(a.reshape(bsz, n_blk, Q_BLOCK, *a.shape[2:]), 1, 0)

    def one_block(args):
        qb, qib, wb, blk = args
        q_pos = blk * Q_BLOCK + jnp.arange(Q_BLOCK)
        causal = key_pos[None, :] <= q_pos[:, None]
        dots = jnp.einsum('bqhd,bsd->bqhs', qib, k_idx).astype(jnp.float32) * IDX_DIM ** -0.5
        score = jnp.einsum('bqh,bqhs->bqs', wb.astype(jnp.float32) * IDX_HEADS ** -0.5,
                           jax.nn.relu(dots))
        score = jnp.where(causal[None], score, -jnp.inf)
        _, sel = lax.top_k(score, topk)
        k_sel = jax.vmap(lambda kk, ii: kk[ii])(k, sel)
        v_sel = jax.vmap(lambda vv, ii: vv[ii])(v, sel)
        valid = sel <= q_pos[None, :, None]
        logits = jnp.einsum('bqhgd,bqshd->bqhgs', qb, k_sel).astype(jnp.float32) * HEAD_DIM ** -0.5
        logits = jnp.where(valid[:, :, None, None, :], logits, -jnp.inf)
        p = jax.nn.softmax(logits, axis=-1).astype(v.dtype)
        return jnp.einsum('bqhgs,bqshd->bqhgd', p, v_sel)

    out = lax.map(one_block, (to_blocks(q), to_blocks(q_idx), to_blocks(w_idx), jnp.arange(n_blk)))
    return jnp.moveaxis(out, 0, 1).reshape(bsz, seq, ATTN_WIDTH)


def swiglu(h, w1, w3, w2):
    return (jax.nn.silu(h @ w1) * (h @ w3)) @ w2


def moe_swiglu(h, router_w, w1, w3, w2):
    n_tok = h.shape[0]
    n_assign = n_tok * TOP_K_EXPERTS
    logits = h.astype(jnp.float32) @ router_w.astype(jnp.float32)
    top_val, top_idx = lax.top_k(logits, TOP_K_EXPERTS)
    gates = jax.nn.softmax(top_val, axis=-1)
    flat_e = top_idx.reshape(-1)
    flat_tok = jnp.repeat(jnp.arange(n_tok, dtype=jnp.int32), TOP_K_EXPERTS)
    flat_g = gates.reshape(-1)
    order = jnp.argsort(flat_e)
    s_e, s_tok, s_g = flat_e[order], flat_tok[order], flat_g[order]
    counts = jnp.bincount(flat_e, length=N_EXPERTS)
    padded = ((counts + MOE_BLOCK - 1) // MOE_BLOCK) * MOE_BLOCK
    start_sorted = jnp.cumsum(counts) - counts
    ends_padded = jnp.cumsum(padded)
    start_padded = ends_padded - padded
    dest = start_padded[s_e] + (jnp.arange(n_assign) - start_sorted[s_e])
    n_rows = -(-(n_assign + N_EXPERTS * (MOE_BLOCK - 1)) // MOE_BLOCK) * MOE_BLOCK
    n_blocks = n_rows // MOE_BLOCK
    buf_tok = jnp.zeros((n_rows,), jnp.int32).at[dest].set(s_tok)
    buf_w = jnp.zeros((n_rows,), jnp.float32).at[dest].set(s_g)
    block_e = jnp.clip(jnp.searchsorted(ends_padded, jnp.arange(n_blocks) * MOE_BLOCK, side='right'),
                       0, N_EXPERTS - 1)
    xin = h[buf_tok].reshape(n_blocks, MOE_BLOCK, h.shape[-1])

    def block_ffn(args):
        xb, e = args
        return swiglu(xb, w1[e], w3[e], w2[e])

    yb = lax.map(block_ffn, (xin, block_e)).reshape(n_rows, h.shape[-1])
    yb = yb * buf_w.astype(h.dtype)[:, None]
    return jnp.zeros_like(h).at[buf_tok].add(yb)


def setup_inputs(seed: int = 0) -> dict:
    key = jax.random.key(seed)
    ks = jax.random.split(key, 17)

    def nrm(k, shape, fan_in):
        return jax.random.normal(k, shape, jnp.float32) * (fan_in ** -0.5)

    def gain(k, shape):
        return 1.0 + 0.02 * jax.random.normal(k, shape, jnp.float32)

    return {
        "x": jax.random.normal(ks[0], (BATCH, SEQ, D_MODEL), jnp.float32),
        "mix_norm": gain(ks[1], (DEPTH, D_MODEL)),
        "w_in": nrm(ks[2], (DEPTH, D_MODEL, IN_COLS), D_MODEL),
        "conv_w": nrm(ks[3], (DEPTH, CONV_K, CONV_CH), CONV_K),
        "w_conv_out": nrm(ks[4], (DEPTH, CONV_CH, D_MODEL), CONV_CH),
        "w_attn_out": nrm(ks[5], (DEPTH, ATTN_WIDTH, D_MODEL), ATTN_WIDTH),
        "w_out": nrm(ks[6], (DEPTH, D_MODEL, D_MODEL), D_MODEL),
        "ffn_norm": gain(ks[7], (DEPTH, D_MODEL)),
        "ffn_w1": nrm(ks[8], (N_DENSE_LAYERS, D_MODEL, D_FF), D_MODEL),
        "ffn_w3": nrm(ks[9], (N_DENSE_LAYERS, D_MODEL, D_FF), D_MODEL),
        "ffn_w2": nrm(ks[10], (N_DENSE_LAYERS, D_FF, D_MODEL), D_FF),
        "router_w": nrm(ks[11], (N_MOE_LAYERS, D_MODEL, N_EXPERTS), D_MODEL),
        "exp_w1": nrm(ks[12], (N_MOE_LAYERS, N_EXPERTS, D_MODEL, D_FF_EXPERT), D_MODEL),
        "exp_w3": nrm(ks[13], (N_MOE_LAYERS, N_EXPERTS, D_MODEL, D_FF_EXPERT), D_MODEL),
        "exp_w2": nrm(ks[14], (N_MOE_LAYERS, N_EXPERTS, D_FF_EXPERT, D_MODEL), D_FF_EXPERT),
        "final_norm": gain(ks[15], (D_MODEL,)),
    }


def reference(x, mix_norm, w_in, conv_w, w_conv_out, w_attn_out, w_out, ffn_norm,
              ffn_w1, ffn_w3, ffn_w2, router_w, exp_w1, exp_w3, exp_w2, final_norm):
    bsz, seq, d = x.shape
    for layer in range(DEPTH):
        h = rmsnorm(x, mix_norm[layer])
        proj = h @ w_in[layer]
        b_g, c_g, u, q, k, v, q_i, k_i, w_i, gate_logits = split_columns(proj)
        y_conv = short_conv_mixer(b_g, c_g, u, conv_w[layer]) @ w_conv_out[layer]
        y_attn = dsa_attention(q.reshape(bsz, seq, N_KV_HEADS, GQA_GROUP, HEAD_DIM),
                               k.reshape(bsz, seq, N_KV_HEADS, HEAD_DIM),
                               v.reshape(bsz, seq, N_KV_HEADS, HEAD_DIM),
                               q_i.reshape(bsz, seq, IDX_HEADS, IDX_DIM),
                               k_i, w_i) @ w_attn_out[layer]
        g_conv, g_attn = jnp.split(jax.nn.sigmoid(gate_logits), N_BRANCHES, axis=-1)
        x = x + (g_conv * y_conv + g_attn * y_attn) @ w_out[layer]
        h = rmsnorm(x, ffn_norm[layer])
        if layer % 2 == 0:
            j = layer // 2
            f = swiglu(h, ffn_w1[j], ffn_w3[j], ffn_w2[j])
        else:
            j = layer // 2
            f = moe_swiglu(h.reshape(bsz * seq, d), router_w[j], exp_w1[j], exp_w3[j],
                           exp_w2[j]).reshape(bsz, seq, d)
        x = x + f
    return rmsnorm(x, final_norm)
```

```cpp
#include <hip/hip_runtime.h>
#include <cstdio>
#include <cstdint>
#include <type_traits>
#ifndef MK_PER_PHASE
#define MK_PER_PHASE 0
#endif
#define DUPMASK_CFG 0u
#define DUPMASK DUPMASK_CFG
namespace pg8 {
#define PG8_LAS __attribute__((address_space(3)))
typedef unsigned short bf16_t;
typedef short bf16x8 __attribute__((ext_vector_type(8)));
typedef float f32x4 __attribute__((ext_vector_type(4)));
typedef unsigned u32x4 __attribute__((ext_vector_type(4)));
constexpr int BM = 256, BK = 64, HALF = 128, HTB = HALF * BK * 2  , STAGE_BYTES = 8 * HTB, NXCD = 8, WGM = 8;

__host__ __device__ __forceinline__ int lds_byte(int r, int c) { const int st = (r >> 4) * 2 + (c >> 5), rr = r & 15, cc = c & 31, ob = rr * 64 + cc * 2; return st * 1024 + (ob ^ (((ob >> 9) & 1) << 5)); }
__host__ __device__ __forceinline__ void stage_rc(int b, int& R, int& C) { const int st = b / 1024, sb = b % 1024, swz = sb ^ (((sb >> 9) & 1) << 5); R = (st >> 1) * 16 + swz / 64; C = (st & 1) * 32 + (swz % 64) / 2; }
__host__ __device__ __forceinline__ int perm32(int rho) { const int n = rho >> 4, i = rho & 15; return 8 * (i >> 2) + 4 * n + (i & 3); }

struct Unit { int pm, pn; int aux = 0; int ks = 0; };
struct Gemm { const bf16_t* A; const bf16_t* Bt; int M, N, K; int Kloop = 0; };

struct StaticOrder {
    int nM, nN, nwg, G, c;
    __host__ __device__ void init(int M, int N, int G_, int c_) { nM = M / BM; nN = N / BM; nwg = nM * nN; G = G_; c = c_; }
    __host__ __device__ bool next(int i, Unit& u) const {
        const long L = (long)i * G + c; if (L >= nwg) return false;
        int wgid = (int)L; { const int q = nwg / NXCD, r = nwg % NXCD, xcd = wgid % NXCD, off = wgid / NXCD; wgid = (xcd < r ? xcd * (q + 1) : r * (q + 1) + (xcd - r) * q) + off; }
        const int nig = WGM * nN, gid = wgid / nig, fm = gid * WGM, gsz = (nM - fm) < WGM ? (nM - fm) : WGM;
        u.pm = fm + ((wgid % nig) % gsz); u.pn = (wgid % nig) / gsz; return true;
    }
    __device__ __forceinline__ void a_ready(const Unit&) const {}
    __device__ __forceinline__ void done(const Unit&) const {}
};
__device__ __forceinline__ unsigned cvt_pk_bf16(float lo, float hi) { unsigned r; asm volatile("v_cvt_pk_bf16_f32 %0, %1, %2" : "=v"(r) : "v"(lo), "v"(hi)); return r; }
typedef int i32x4_t __attribute__((ext_vector_type(4))); typedef int i32x8_t __attribute__((ext_vector_type(8)));
template <class Epi, class Sched, bool ALIGN_EPI = false, bool SP2 = false, bool FP8 = false>
__device__ __forceinline__ void gemm_phase(PG8_LAS unsigned char* lds, const Gemm g, const Sched& S, const Epi& E) {
    int tid_ = threadIdx.x; asm volatile("" : "+v"(tid_));
    const int tid = tid_, wid = __builtin_amdgcn_readfirstlane(tid >> 6), lane = tid & 63, wr = wid >> 2, wc = wid & 3, fr = lane & 15, fq = lane >> 4;
    const int K = g.K, Kl = g.Kloop ? g.Kloop : g.K, nt = Kl / BK; const size_t ksl = (size_t)Kl * 2;
    unsigned voffA[2], voffB[2];
#pragma unroll
    for (int i = 0; i < 2; ++i) { int R, C; stage_rc(tid * 16 + i * 8192, R, C); const int Rb = Epi::PERM ? ((R & ~31) + perm32(R & 31)) : R;
        voffA[i] = (unsigned)(R * K + C) * 2u; voffB[i] = (unsigned)(Rb * K + C) * 2u; }
    const size_t kstep = (size_t)(BK * 2);
    const size_t hstep = (size_t)HALF * K * 2;
    const size_t tstep = 2 * hstep;
    const unsigned ldsw = (unsigned)wid * 1024u; const unsigned ldsbase = (unsigned)__builtin_amdgcn_readfirstlane((int)((unsigned)(size_t)lds + ldsw));
    int aoff = lds_byte(wr * 64 + fr, fq * 8), boff = lds_byte(wc * 32 + fr, fq * 8);
    int boffB = boff + 4 * HTB;
    asm volatile("" : "+v"(aoff), "+v"(boffB));
#define PG8_SA(b, h) (((b) * 2 + (h)) * HTB)
#define PG8_SB(b, h) ((4 + (b) * 2 + (h)) * HTB)
#define PG8_GLDS(sbase, vo, ldsaddr) asm volatile("s_mov_b32 m0, %2\n\ts_nop 0\n\tglobal_load_lds_dwordx4 %0, %1" :: "v"(vo), "s"(sbase), "s"(ldsaddr) : "memory")
#define PG8_STAGE(bufoff, gbase, voff) do { _Pragma("unroll") for (int _i = 0; _i < 2; ++_i) PG8_GLDS((const char*)(gbase), (voff)[_i], ldsbase + (unsigned)((bufoff) + _i * 8192)); } while (0)
#define PG8_RD16(off) (*(const PG8_LAS i32x4_t*)(lds + (off)))
#define PG8_LDA(dst, b, h) do { _Pragma("unroll") for (int m = 0; m < 4; ++m) { if constexpr (FP8) { dst##8[m] = __builtin_shufflevector(PG8_RD16(PG8_SA(b, h) + aoff + m * 2048), PG8_RD16(PG8_SA(b, h) + aoff + m * 2048 + 1024), 0, 1, 2, 3, 4, 5, 6, 7); } \
        else { _Pragma("unroll") for (int k = 0; k < 2; ++k) dst[m][k] = *(const PG8_LAS bf16x8*)(lds + PG8_SA(b, h) + aoff + m * 2048 + k * 1024); } } } while (0)
#define PG8_LDB(dst, b, h) do { _Pragma("unroll") for (int n = 0; n < 2; ++n) { if constexpr (FP8) { dst##8[n] = __builtin_shufflevector(PG8_RD16(PG8_SA(b, h) + boffB + n * 2048), PG8_RD16(PG8_SA(b, h) + boffB + n * 2048 + 1024), 0, 1, 2, 3, 4, 5, 6, 7); } \
        else { _Pragma("unroll") for (int k = 0; k < 2; ++k) dst[n][k] = *(const PG8_LAS bf16x8*)(lds + PG8_SA(b, h) + boffB + n * 2048 + k * 1024); } } } while (0)
#define PG8_MMA(ai, bj, At, Bt) do { __builtin_amdgcn_s_setprio(1); _Pragma("unroll") for (int m = 0; m < 4; ++m) _Pragma("unroll") for (int n = 0; n < 2; ++n) { \
        if constexpr (FP8) { asm("s_nop 1\n\tv_mfma_scale_f32_16x16x128_f8f6f4 %0, %1, %2, %0, %3, %3 op_sel_hi:[0,0,0]" : "+v"(acc[ai][bj][m][n]) : "v"(Bt##8[n]), "v"(At##8[m]), "v"(f8scale)); } \
        else { _Pragma("unroll") for (int k = 0; k < 2; ++k) acc[ai][bj][m][n] = __builtin_amdgcn_mfma_f32_16x16x32_bf16(Bt[n][k], At[m][k], acc[ai][bj][m][n], 0, 0, 0); } } \
        __builtin_amdgcn_s_setprio(0); } while (0)
#define PG8_WAIT_V(n) asm volatile("s_waitcnt vmcnt(" #n ")" ::: "memory")
#define PG8_WAIT_V8() do { if constexpr (Epi::NST > 0) { if (t == 0 && ui > 0) asm volatile("s_waitcnt vmcnt(%0)" :: "n"(8 + Epi::NST) : "memory"); else PG8_WAIT_V(8); } else PG8_WAIT_V(8); } while (0)
#define PG8_WAIT_L(n) asm volatile("s_waitcnt lgkmcnt(" #n ")" ::: "memory")
#define PG8_BAR __builtin_amdgcn_s_barrier()
#define PG8_SCHED __builtin_amdgcn_sched_barrier(0)
    Unit cur, nxt; int ui = 0;
    if (!S.next(0, cur)) return;
    f32x4 acc[2][2][4][2];
#pragma unroll
    for (int a = 0; a < 2; ++a)
#pragma unroll
        for (int b = 0; b < 2; ++b)
#pragma unroll
            for (int m = 0; m < 4; ++m)
#pragma unroll
                for (int n = 0; n < 2; ++n) acc[a][b][m][n] = (f32x4){0.f, 0.f, 0.f, 0.f};
    bf16x8 At[4][2], B0[2][2], B1[2][2]; i32x8_t At8[4], B08[2], B18[2]; int f8scale = 0x7F7F7F7F; asm volatile("" : "+v"(f8scale));
    const char* cA = (const char*)g.A + (size_t)__builtin_amdgcn_readfirstlane(cur.pm) * tstep + (size_t)__builtin_amdgcn_readfirstlane(cur.ks) * ksl; const char* cB = (const char*)g.Bt + (size_t)__builtin_amdgcn_readfirstlane(cur.pn) * tstep + (size_t)__builtin_amdgcn_readfirstlane(cur.ks) * ksl;
    S.a_ready(cur);
    if constexpr (SP2) {
        PG8_STAGE(PG8_SB(0, 0), cB, voffB); PG8_STAGE(PG8_SB(0, 1), cB + hstep, voffB); PG8_STAGE(PG8_SA(0, 0), cA, voffA); PG8_STAGE(PG8_SA(0, 1), cA + hstep, voffA);
        if (wr == 1) PG8_BAR;
        PG8_WAIT_V(2); PG8_BAR;
        PG8_STAGE(PG8_SB(1, 0), cB + kstep, voffB); PG8_STAGE(PG8_SA(1, 0), cA + kstep, voffA); PG8_STAGE(PG8_SB(1, 1), cB + hstep + kstep, voffB);
        PG8_WAIT_V(6); PG8_BAR;
    } else {
        PG8_STAGE(PG8_SB(0, 0), cB, voffB); PG8_STAGE(PG8_SA(0, 0), cA, voffA); PG8_STAGE(PG8_SB(0, 1), cB + hstep, voffB); PG8_STAGE(PG8_SA(0, 1), cA + hstep, voffA);
        if (wr == 1) PG8_BAR;
        PG8_WAIT_V(4); PG8_BAR;
        PG8_STAGE(PG8_SB(1, 0), cB + kstep, voffB); PG8_STAGE(PG8_SA(1, 0), cA + kstep, voffA); PG8_STAGE(PG8_SB(1, 1), cB + hstep + kstep, voffB);
        PG8_WAIT_V(6); PG8_BAR;
    }
    for (;;) {
        const bool has_next = S.next(ui + 1, nxt);
        const char* nA = has_next ? (const char*)g.A + (size_t)__builtin_amdgcn_readfirstlane(nxt.pm) * tstep + (size_t)__builtin_amdgcn_readfirstlane(nxt.ks) * ksl : cA; const char* nB = has_next ? (const char*)g.Bt + (size_t)__builtin_amdgcn_readfirstlane(nxt.pn) * tstep + (size_t)__builtin_amdgcn_readfirstlane(nxt.ks) * ksl : cB;
        for (int t = 0; t < nt; t += 2) {
            const bool last = (t == nt - 2);
            const char* a1 = cA + (size_t)(t + 1) * kstep;
            const char* a2 = last ? nA : cA + (size_t)(t + 2) * kstep; const char* b2 = last ? nB : cB + (size_t)(t + 2) * kstep;
            const char* a3 = a2 + kstep; const char* b3 = b2 + kstep;
            if (last && has_next) S.a_ready(nxt);
            if constexpr (Epi::HAS_MID) { if (t == nt / 2) { int fr_ = fr, fq_ = fq; asm volatile("" : "+v"(fr_), "+v"(fq_)); E.mid(acc, cur, wr, wc, fr_, fq_); } }
            if constexpr (SP2) {
            PG8_LDB(B0, 0, 0); PG8_LDB(B1, 0, 1); PG8_SCHED; PG8_LDA(At, 0, 0); PG8_STAGE(PG8_SA(1, 1), a1 + hstep, voffA);
            PG8_WAIT_V8(); PG8_WAIT_L(0); PG8_BAR; PG8_MMA(0, 0, At, B0); PG8_MMA(0, 1, At, B1); PG8_BAR; PG8_SCHED;
            PG8_LDA(At, 0, 1); PG8_STAGE(PG8_SB(0, 0), b2, voffB); PG8_STAGE(PG8_SB(0, 1), b2 + hstep, voffB); PG8_STAGE(PG8_SA(0, 0), a2, voffA);
            PG8_WAIT_V8(); PG8_WAIT_L(0); PG8_BAR; PG8_MMA(1, 0, At, B0); PG8_MMA(1, 1, At, B1); PG8_BAR; PG8_SCHED;
            PG8_LDB(B0, 1, 0); PG8_LDB(B1, 1, 1); PG8_SCHED; PG8_LDA(At, 1, 0); PG8_STAGE(PG8_SA(0, 1), a2 + hstep, voffA);
            PG8_WAIT_V8(); PG8_WAIT_L(0); PG8_BAR; PG8_MMA(0, 0, At, B0); PG8_MMA(0, 1, At, B1); PG8_BAR; PG8_SCHED;
            PG8_LDA(At, 1, 1); PG8_STAGE(PG8_SB(1, 0), b3, voffB); PG8_STAGE(PG8_SB(1, 1), b3 + hstep, voffB); PG8_STAGE(PG8_SA(1, 0), a3, voffA);
            PG8_WAIT_V8(); PG8_WAIT_L(0); PG8_BAR; PG8_MMA(1, 0, At, B0); PG8_MMA(1, 1, At, B1); PG8_BAR; PG8_SCHED;
            } else {
            PG8_LDB(B0, 0, 0); PG8_SCHED; PG8_LDA(At, 0, 0); PG8_STAGE(PG8_SA(1, 1), a1 + hstep, voffA);
            PG8_WAIT_L(8); PG8_BAR; PG8_WAIT_L(0); PG8_MMA(0, 0, At, B0); PG8_BAR; PG8_SCHED;
            PG8_LDB(B1, 0, 1); PG8_STAGE(PG8_SB(0, 0), b2, voffB);
            PG8_BAR; PG8_WAIT_L(0); PG8_MMA(0, 1, At, B1); PG8_BAR;
            PG8_LDA(At, 0, 1); PG8_STAGE(PG8_SA(0, 0), a2, voffA);
            PG8_BAR; PG8_WAIT_L(0); PG8_MMA(1, 0, At, B0); PG8_BAR; PG8_SCHED;
            PG8_STAGE(PG8_SB(0, 1), b2 + hstep, voffB);
            PG8_WAIT_V(6); PG8_BAR; PG8_MMA(1, 1, At, B1); PG8_BAR;
            PG8_LDB(B0, 1, 0); PG8_SCHED; PG8_LDA(At, 1, 0); PG8_STAGE(PG8_SA(0, 1), a2 + hstep, voffA);
            PG8_WAIT_L(8); PG8_BAR; PG8_WAIT_L(0); PG8_MMA(0, 0, At, B0); PG8_BAR; PG8_SCHED;
            PG8_LDB(B1, 1, 1); PG8_STAGE(PG8_SB(1, 0), b3, voffB);
            PG8_BAR; PG8_WAIT_L(0); PG8_MMA(0, 1, At, B1); PG8_BAR;
            PG8_LDA(At, 1, 1); PG8_STAGE(PG8_SA(1, 0), a3, voffA);
            PG8_BAR; PG8_WAIT_L(0); PG8_MMA(1, 0, At, B0); PG8_BAR; PG8_SCHED;
            PG8_STAGE(PG8_SB(1, 1), b3 + hstep, voffB);
            PG8_WAIT_V(6); PG8_BAR; PG8_MMA(1, 1, At, B1); PG8_BAR;
            }
        }
        if constexpr (ALIGN_EPI) { if (wr == 0) PG8_BAR; }
        if constexpr (FP8) asm volatile("s_nop 15\n\ts_nop 15" ::: "memory");
        if constexpr (!Epi::AFTER_DRAIN) { int fr_ = fr, fq_ = fq; asm volatile("" : "+v"(fr_), "+v"(fq_));
            E(acc, cur, wr, wc, fr_, fq_);
#if defined(PROBE_EPIDUP)
            if constexpr (!Epi::NOT_IDEMPOTENT) { asm volatile("" : "+v"(fr_), "+v"(fq_)); E(acc, cur, wr, wc, fr_, fq_); }
#endif
            S.done(cur); }
        if (!has_next) break;
#pragma unroll
        for (int a = 0; a < 2; ++a)
#pragma unroll
            for (int b = 0; b < 2; ++b)
#pragma unroll
                for (int m = 0; m < 4; ++m)
#pragma unroll
                    for (int n = 0; n < 2; ++n) acc[a][b][m][n] = (f32x4){0.f, 0.f, 0.f, 0.f};
        cur = nxt; cA = nA; cB = nB; ++ui;
        if constexpr (ALIGN_EPI) { if (wr == 1) PG8_BAR; }
    }
    PG8_WAIT_V(0);
    if constexpr (!ALIGN_EPI) { if (wr == 0) PG8_BAR; }
    PG8_BAR;
    if constexpr (Epi::AFTER_DRAIN) { E.fused(acc, cur, wr, wc, fr, fq, lds, wid, lane); S.done(cur); }
#undef PG8_SA
#undef PG8_SB
#undef PG8_STAGE
#undef PG8_GLDS
#undef PG8_LDA
#undef PG8_LDB
#undef PG8_MMA
#undef PG8_RD16
#undef PG8_WAIT_V
#undef PG8_WAIT_V8
#undef PG8_WAIT_L
#undef PG8_BAR
#undef PG8_SCHED
}
}

constexpr int NB = 8, T = 2048, D = 2048, NTOK = NB * T;
constexpr int INC = 9808, INP = 9984, NPT = INP / 256;
constexpr int FF = 5632, NE = 8, FFE = 7168, TOPK = 256;
constexpr int MAXROWS = 34816;
constexpr float RMS_EPS = 1e-6f;
constexpr int NWAVES = 8, NTHR = 512;

constexpr size_t MiB = 1u << 20;
constexpr size_t WS_CTL = 0, CTL_ZERO_BYTES = 1 * MiB;
constexpr size_t WS_W0 = 1 * MiB;
constexpr size_t WS_H = 40 * MiB;
constexpr size_t WS_W1 = 104 * MiB;
constexpr size_t WS_WC = 143 * MiB;
constexpr size_t WS_WA = 151 * MiB;
constexpr size_t WS_WO = 159 * MiB;
constexpr size_t WS_W13 = 175 * MiB;
constexpr size_t WS_W2 = 219 * MiB;
constexpr size_t WS_EW13 = 241 * MiB;
constexpr size_t WS_EW2 = 689 * MiB;
constexpr size_t WS_XA = 913 * MiB;
constexpr size_t WS_XB = 1041 * MiB;
constexpr size_t WS_S = 1169 * MiB;
constexpr size_t WS_BCU = WS_S;
constexpr size_t WS_Q = WS_S + 96 * MiB;
constexpr size_t WS_K = WS_S + 128 * MiB;
constexpr size_t WS_VT = WS_S + 136 * MiB;
constexpr size_t WS_QI = WS_S + 144 * MiB;
constexpr size_t WS_KW = WS_S + 176 * MiB;
constexpr size_t WS_GT = WS_S + 184 * MiB;
constexpr size_t WS_MASK = WS_S + 312 * MiB;
constexpr size_t WS_YMIX = WS_S + 316 * MiB;
constexpr size_t WS_ATT = WS_S + 348 * MiB;
constexpr size_t WS_Z = WS_S + 380 * MiB;
constexpr size_t WS_ACT = WS_XB + 32 * MiB;
constexpr int ECAP = 16384, ECAPT = ECAP / 256;
constexpr size_t WS_XIN = WS_S;
constexpr size_t WS_EACT = WS_S + 256 * MiB;
constexpr size_t WS_MISC = 1781 * MiB;
constexpr size_t WS_ROWTOK = WS_MISC, WS_ROWW = WS_MISC + 512 * 1024;
constexpr size_t WS_SLAB = 1783 * MiB;
constexpr size_t WS_RMS0 = 1787 * MiB;
constexpr size_t WS_END = 1788 * MiB;
constexpr int CW_CNT = 64;
constexpr int CW_QI = 128, CW_QA = 192;
constexpr int CW_BAR = 4096;
constexpr int CW_GB = 8192;
constexpr int CW_BB = 12288;
constexpr int CW_XID = 16384;

constexpr int RING_BYTES = 131072;
constexpr int MISC_OFF = RING_BYTES + 320;
constexpr int QSLOT_OFF = RING_BYTES + 8192;
constexpr int RSTD_OFF = RING_BYTES + 4096;
constexpr int LDS_BYTES = 147456;

#define GAS __attribute__((address_space(1)))
#define LAS __attribute__((address_space(3)))
typedef unsigned short bf16;
typedef unsigned v4u __attribute__((ext_vector_type(4)));
typedef unsigned v2u __attribute__((ext_vector_type(2)));
typedef float f32x4 __attribute__((ext_vector_type(4)));
typedef float f32x16 __attribute__((ext_vector_type(16)));
typedef float f32x2 __attribute__((ext_vector_type(2)));
typedef short bf16x8 __attribute__((ext_vector_type(8)));
typedef GAS unsigned gu32;
#define RLX_AGENT __ATOMIC_RELAXED, __HIP_MEMORY_SCOPE_AGENT
#define LDS_WAIT() asm volatile("s_waitcnt lgkmcnt(0)" ::: "memory")
#define VM_WAIT() asm volatile("s_waitcnt vmcnt(0)" ::: "memory")
__device__ __forceinline__ unsigned pk2(float lo, float hi) { return pg8::cvt_pk_bf16(lo, hi); }
__device__ __forceinline__ float bflo(unsigned w) { return __builtin_bit_cast(float, w << 16); }
__device__ __forceinline__ float bfhi(unsigned w) { return __builtin_bit_cast(float, w & 0xffff0000u); }
__device__ __forceinline__ float fast_exp2(float x) { return __builtin_amdgcn_exp2f(x); }
__device__ __forceinline__ float sigmoidf_(float x) { return __builtin_amdgcn_rcpf(1.0f + fast_exp2(-1.4426950408889634f * x)); }
__device__ __forceinline__ float siluf_(float x) { return x * sigmoidf_(x); }
__device__ __forceinline__ unsigned pk4_fp8(float a, float b, float c, float d) {
    a = __builtin_amdgcn_fmed3f(a, -448.f, 448.f); b = __builtin_amdgcn_fmed3f(b, -448.f, 448.f); c = __builtin_amdgcn_fmed3f(c, -448.f, 448.f); d = __builtin_amdgcn_fmed3f(d, -448.f, 448.f);
    int w = 0; w = __builtin_amdgcn_cvt_pk_fp8_f32(a, b, w, false); w = __builtin_amdgcn_cvt_pk_fp8_f32(c, d, w, true); return (unsigned)w; }
constexpr int NCONV = 64;
constexpr int CONV_PROLOGUE_PCT = 0;
constexpr int CONV_S1_PCT = 17, CONV_S2_PCT = 8;
constexpr bool FUSE_RMS = true;
constexpr bool F8_FFN = true;
constexpr float F8_SW = 256.f, F8_SA = 8.f, F8_SACT = 8.f;
__device__ __forceinline__ float wave_sum(float v) {
#pragma unroll
    for (int o = 1; o < 64; o <<= 1) v += __shfl_xor(v, o);
    return v;
}
#define XB_TMO      128
#define XB_XCNT(j)  (256  + 64 * (j))
#define XB_XSUB(j)  (1280 + 64 * (j))
#define XB_XGEN(j)  (2304 + 64 * (j))
#define XB_TOP      3328
#define XB_TOPGEN   3392
#define XCD_BAR_WORDS 3456
#define XB_SPIN_CAP (1u << 18)

__device__ __forceinline__ unsigned xb_ld(unsigned* p)              { return __hip_atomic_load(p, __ATOMIC_RELAXED, __HIP_MEMORY_SCOPE_AGENT); }
__device__ __forceinline__ unsigned xb_add(unsigned* p, unsigned v) { return __hip_atomic_fetch_add(p, v, __ATOMIC_RELAXED, __HIP_MEMORY_SCOPE_AGENT); }
__device__ __forceinline__ unsigned xb_xcc_id() { return (unsigned)__builtin_amdgcn_s_getreg((3 << 11) | 20) & 0xFu; }
#define XB_SPIN(cond, bar) do { unsigned _sp = 0; while (cond) { __builtin_amdgcn_s_sleep(1); \
    if ((++_sp & 255u) == 0u) { if (xb_ld(&(bar)[XB_TMO])) break; if (_sp > XB_SPIN_CAP) { atomicAdd(&(bar)[XB_TMO], 1u); break; } } } } while (0)

struct XcdBarrier {
    unsigned* bar; unsigned x;
    volatile LAS unsigned* st;
};

__device__ __forceinline__ XcdBarrier xcd_barrier_post(unsigned* bar, volatile LAS unsigned* st) {
    XcdBarrier b; b.bar = bar; b.x = xb_xcc_id(); b.st = st;
    if (threadIdx.x == 0) (void)xb_add(&bar[XB_XCNT(b.x)], 1u);
    return b;
}
__device__ __forceinline__ void xcd_barrier_complete(unsigned* bar, unsigned x, unsigned& nloc, unsigned& nx) {
    const unsigned G = gridDim.x * gridDim.y * gridDim.z;
    unsigned sum, cnt, mine, sp = 0u;
    for (;;) {
        sum = 0u; cnt = 0u; mine = 0u;
#pragma unroll
        for (unsigned j = 0; j < 16; ++j) { const unsigned c = xb_ld(&bar[XB_XCNT(j)]); sum += c; cnt += (c > 0u) ? 1u : 0u; mine = (j == x) ? c : mine; }
        if (sum == G) break;
        __builtin_amdgcn_s_sleep(1);
        if ((++sp & 255u) == 0u) { if (xb_ld(&bar[XB_TMO])) break; if (sp > XB_SPIN_CAP) { atomicAdd(&bar[XB_TMO], 1u); break; } }
    }
    nloc = mine > 0u ? mine : 1u; nx = cnt > 0u ? cnt : 1u;
}

__device__ __forceinline__ void xcd_barrier(const XcdBarrier& b) {
    asm volatile("s_waitcnt vmcnt(0)" ::: "memory");
    __syncthreads();
    if (threadIdx.x == 0) {
        unsigned* bar = b.bar;
        __builtin_amdgcn_s_waitcnt(0);
        unsigned nloc = b.st[0], nx = b.st[1];
        if (nloc == 0u) { xcd_barrier_complete(bar, b.x, nloc, nx); b.st[0] = nloc; b.st[1] = nx; }
        const unsigned old = xb_add(&bar[XB_XSUB(b.x)], 1u);
        const unsigned gen = old / nloc;
        if (old + 1u == (gen + 1u) * nloc) {
            __builtin_amdgcn_fence(__ATOMIC_RELEASE, "agent");
            asm volatile("s_waitcnt vmcnt(0)" ::: "memory");
            const unsigned og = xb_add(&bar[XB_TOP], 1u);
            const unsigned tg = og / nx;
            if (og + 1u == (tg + 1u) * nx) xb_add(&bar[XB_TOPGEN], 1u);
            else XB_SPIN(xb_ld(&bar[XB_TOPGEN]) == tg, bar);
            __builtin_amdgcn_fence(__ATOMIC_ACQUIRE, "agent");
            xb_add(&bar[XB_XGEN(b.x)], 1u);
            asm volatile("s_waitcnt vmcnt(0)" ::: "memory");
        } else {
            XB_SPIN(xb_ld(&bar[XB_XGEN(b.x)]) == gen, bar);
            __builtin_amdgcn_fence(__ATOMIC_ACQUIRE, "agent");
            asm volatile("s_waitcnt vmcnt(0)" ::: "memory");
        }
    }
    __syncthreads();
}

__device__ __forceinline__ void group_barrier(unsigned* ctl, int c, unsigned target, volatile LAS unsigned* st) {
    asm volatile("s_waitcnt vmcnt(0)" ::: "memory");
    __syncthreads();
    if (threadIdx.x == 0) {
        __builtin_amdgcn_s_waitcnt(0);
        unsigned same = st[0];
        if (same == 0u) { const unsigned i0 = xb_ld(&ctl[CW_XID + (c & 63)]), i1 = xb_ld(&ctl[CW_XID + (c & 63) + 64]), i2 = xb_ld(&ctl[CW_XID + (c & 63) + 128]), i3 = xb_ld(&ctl[CW_XID + (c & 63) + 192]);
            same = (i0 != 0u && i0 == i1 && i0 == i2 && i0 == i3) ? 1u : 2u; st[0] = same; }
        unsigned* w = &ctl[CW_GB + 64 * (c & 63)];
        if (same != 1u) { __builtin_amdgcn_fence(__ATOMIC_RELEASE, "agent"); asm volatile("s_waitcnt vmcnt(0)" ::: "memory"); }
        (void)xb_add(w, 1u);
        XB_SPIN(xb_ld(w) < target, ctl + CW_BAR);
        __builtin_amdgcn_fence(__ATOMIC_ACQUIRE, "agent");
        asm volatile("s_waitcnt vmcnt(0)" ::: "memory");
    }
    __syncthreads();
}

__device__ __forceinline__ void batch_barrier(unsigned* ctl, int c, unsigned target, volatile LAS unsigned* st) {
    asm volatile("s_waitcnt vmcnt(0)" ::: "memory");
    __syncthreads();
    if (threadIdx.x == 0) {
        __builtin_amdgcn_s_waitcnt(0);
        unsigned same = st[0];
        if (same == 0u) { const unsigned i0 = xb_ld(&ctl[CW_XID + (c & 7)]); bool eq = (i0 != 0u);
            for (int j = 1; j < 32; ++j) eq = eq && (xb_ld(&ctl[CW_XID + (c & 7) + 8 * j]) == i0);
            same = eq ? 1u : 2u; st[0] = same; }
        unsigned* w = &ctl[CW_BB + 64 * (c & 7)];
        if (same != 1u) { __builtin_amdgcn_fence(__ATOMIC_RELEASE, "agent"); asm volatile("s_waitcnt vmcnt(0)" ::: "memory"); }
        (void)xb_add(w, 1u);
        XB_SPIN(xb_ld(w) < target, ctl + CW_BAR);
        __builtin_amdgcn_fence(__ATOMIC_ACQUIRE, "agent");
        asm volatile("s_waitcnt vmcnt(0)" ::: "memory");
    }
    __syncthreads();
}

struct Frame {
    LAS unsigned char* lds;
    unsigned char* ws;
    int tid, lane, wave, G, vcu;
};
__device__ __forceinline__ Frame fresh(const Frame& F) {
    Frame R = F; int t = F.tid; asm volatile("" : "+v"(t)); unsigned long long w = (unsigned long long)F.ws; asm volatile("" : "+s"(w));
    R.tid = t; R.lane = t & 63; R.wave = __builtin_amdgcn_readfirstlane(t >> 6); R.ws = (unsigned char*)w; return R; }
#define CAS __attribute__((address_space(4)))
struct Args { const float* in[16]; float* out; unsigned char* ws; int ph_lo, ph_hi; };

__device__ __forceinline__ void decode_unit(int L, int nM, int nN, int& pm, int& pn) {
    const int nwg = nM * nN;
    int wgid = L; { const int q = nwg / 8, r = nwg % 8, xcd = wgid % 8, off = wgid / 8; wgid = (xcd < r ? xcd * (q + 1) : r * (q + 1) + (xcd - r) * q) + off; }
    const int nig = 8 * nN, gid = wgid / nig, fm = gid * 8, gsz = (nM - fm) < 8 ? (nM - fm) : 8;
    pm = fm + ((wgid % nig) % gsz); pn = (wgid % nig) / gsz;
}
struct PlainOrder {
    int nM, nN, G, c, aoff, boff;
    __device__ __forceinline__ bool next(int i, pg8::Unit& u) const {
        const long L = (long)i * G + c; if (L >= (long)nM * nN) return false;
        int pm, pn; decode_unit((int)L, nM, nN, pm, pn); u.pm = aoff + pm; u.pn = boff + pn; return true; }
    __device__ __forceinline__ void a_ready(const pg8::Unit&) const {}
    __device__ __forceinline__ void done(const pg8::Unit&) const {}
};
struct ProjOrder {
    int G, c, hA0, wB0;
    __device__ __forceinline__ bool next(int i, pg8::Unit& u) const {
        const long L = (long)i * G + c; if (L >= 64L * NPT) return false;
        int pm, pn; decode_unit((int)L, 64, NPT, pm, pn);
        if (pn == 17) { u.pm = wB0 + 17; u.pn = hA0 + pm; } else { u.pm = hA0 + pm; u.pn = wB0 + pn; }
        return true; }
    __device__ __forceinline__ void a_ready(const pg8::Unit&) const {}
    __device__ __forceinline__ void done(const pg8::Unit&) const {}
};
struct MoeOrder {
    int G, c, nN, Tm, t1, t2, t3, t4, t5, t6, t7, sparseA;
    int limit = 0x7fffffff;
    __device__ __forceinline__ int expert_of(int pm) const { return (pm >= t1) + (pm >= t2) + (pm >= t3) + (pm >= t4) + (pm >= t5) + (pm >= t6) + (pm >= t7); }
    __device__ __forceinline__ int first_of(int e) const { return e == 0 ? 0 : (e == 1 ? t1 : (e == 2 ? t2 : (e == 3 ? t3 : (e == 4 ? t4 : (e == 5 ? t5 : (e == 6 ? t6 : t7)))))); }
    __device__ __forceinline__ bool next(int i, pg8::Unit& u) const {
        const long L = (long)i * G + c; if (L >= (long)Tm * nN || L >= limit) return false;
        return unit_of((int)L, u); }
    __device__ __forceinline__ bool unit_of(int L, pg8::Unit& u) const {
        int pm, pn; decode_unit(L, Tm, nN, pm, pn); const int e = expert_of(pm), sp = e * ECAPT + (pm - first_of(e));
        u.pm = sparseA ? sp : pm; u.aux = sparseA ? pm : sp; u.pn = e * nN + pn; return true; }
    __device__ __forceinline__ void a_ready(const pg8::Unit&) const {}
    __device__ __forceinline__ void done(const pg8::Unit&) const {}
};

struct MoeTailOrder {
    MoeOrder M; int first, R, S;
    __device__ __forceinline__ bool next(int i, pg8::Unit& u) const {
        if (i > 0 || M.c >= R * S) return false;
        M.unit_of(first + M.c / S, u); u.ks = M.c % S; return true; }
    __device__ __forceinline__ void a_ready(const pg8::Unit&) const {}
    __device__ __forceinline__ void done(const pg8::Unit&) const {}
};
__device__ __forceinline__ int tail_slices(int R) { return R == 0 ? 1 : (R * 14 <= 256 ? 14 : (R * 7 <= 256 ? 7 : (R * 4 <= 256 ? 4 : (R * 2 <= 256 ? 2 : 1)))); }
typedef const pg8::f32x4 (&AccRef)[2][2][4][2];
__device__ __forceinline__ v4u pack8(f32x4 a, f32x4 b) { v4u w; w.x = pk2(a[0], a[1]); w.y = pk2(a[2], a[3]); w.z = pk2(b[0], b[1]); w.w = pk2(b[2], b[3]); return w; }
__device__ __forceinline__ void unpack8(v4u w, f32x4& a, f32x4& b) { a = (f32x4){bflo(w.x), bfhi(w.x), bflo(w.y), bfhi(w.y)}; b = (f32x4){bflo(w.z), bfhi(w.z), bflo(w.w), bfhi(w.w)}; }

struct EpiProj {
    static constexpr bool PERM = true, AFTER_DRAIN = false, NOT_IDEMPOTENT = false, HAS_MID = false; static constexpr int NST = 0;
    unsigned char* ws; int hA0, wB0; const LAS float* rstd;
    __device__ __forceinline__ void operator()(AccRef acc, const pg8::Unit& u, int wr, int wc, int fr, int fq) const {
        bf16* base; int ldc, mode = 0, rowbase; const bool vt = (u.pm >= wB0 && u.pm < wB0 + NPT);
        if (vt) { base = (bf16*)(ws + WS_VT) + (size_t)(u.pn - hA0) * 256; ldc = NTOK; rowbase = 0; }
        else {
            const int ct = u.pn - wB0; rowbase = (u.pm - hA0) * 256;
            if (ct < 12) { base = (bf16*)(ws + WS_BCU) + ct * 256; ldc = 3072; }
            else if (ct < 16) { base = (bf16*)(ws + WS_Q) + (ct - 12) * 256; ldc = 1024; }
            else if (ct == 16) { base = (bf16*)(ws + WS_K); ldc = 256; }
            else if (ct < 22) { base = (bf16*)(ws + WS_QI) + (ct - 18) * 256; ldc = 1024; }
            else if (ct < 38) { base = (bf16*)(ws + WS_GT) + (ct - 22) * 128; ldc = 4096; mode = 1; }
            else { base = (bf16*)(ws + WS_KW); ldc = 256; }
        }
        const int row0 = rowbase + wr * 64 + fr, col0 = wc * 32 + 8 * fq;
#pragma unroll
        for (int ai = 0; ai < 2; ++ai)
#pragma unroll
            for (int m = 0; m < 4; ++m) { bf16* rowp = base + (size_t)(row0 + ai * 128 + m * 16) * ldc + col0;
                const float rs = (rstd && !vt) ? rstd[ai * 128 + wr * 64 + m * 16 + fr] : 1.0f;
                if (mode) {
                    f32x4 r0, r1, a0, a1; const float nl = -1.4426950408889634f * rs;
#pragma unroll
                    for (int j = 0; j < 4; ++j) { const float ea0 = 1.0f + fast_exp2(acc[ai][0][m][0][j] * nl), eb0 = 1.0f + fast_exp2(acc[ai][1][m][0][j] * nl), ea1 = 1.0f + fast_exp2(acc[ai][0][m][1][j] * nl), eb1 = 1.0f + fast_exp2(acc[ai][1][m][1][j] * nl);
                        a0[j] = __builtin_amdgcn_rcpf(eb0); a1[j] = __builtin_amdgcn_rcpf(eb1); r0[j] = eb0 * __builtin_amdgcn_rcpf(ea0); r1[j] = eb1 * __builtin_amdgcn_rcpf(ea1); }
                    *(GAS v4u*)(rowp) = pack8(r0, r1); *(GAS v4u*)(rowp + 2048) = pack8(a0, a1);
                } else {
#pragma unroll
                for (int bj = 0; bj < 2; ++bj) { f32x4 v0 = acc[ai][bj][m][0] * rs, v1 = acc[ai][bj][m][1] * rs;
                    if (rstd && vt) { const LAS f32x4* rp = (const LAS f32x4*)(rstd + bj * 128 + wc * 32 + 8 * fq); v0 = v0 * rp[0]; v1 = v1 * rp[1]; }
                    *(GAS v4u*)(rowp + bj * 128) = pack8(v0, v1); } } }
    }
};
template <int MODE  > struct EpiGate {
    static constexpr bool PERM = true, AFTER_DRAIN = false, NOT_IDEMPOTENT = (MODE == 1), HAS_MID = false; static constexpr int NST = 0;
    unsigned char* ws;
    __device__ __forceinline__ void operator()(AccRef acc, const pg8::Unit& u, int wr, int wc, int fr, int fq) const {
        const int row0 = u.pm * 256 + wr * 64 + fr, col0 = u.pn * 256 + wc * 32 + 8 * fq;
        bf16* Z = (bf16*)(ws + WS_Z); const bf16* GT = (const bf16*)(ws + WS_GT) + MODE * 2048;
#pragma unroll
        for (int ai = 0; ai < 2; ++ai)
#pragma unroll
            for (int m = 0; m < 4; ++m) { const size_t r = (size_t)(row0 + ai * 128 + m * 16);
#pragma unroll
                for (int bj = 0; bj < 2; ++bj) { const int c = col0 + bj * 128;
                    f32x4 g0, g1; unpack8(*(const GAS v4u*)(GT + r * 4096 + c), g0, g1);
                    f32x4 v0 = acc[ai][bj][m][0] * g0, v1 = acc[ai][bj][m][1] * g1;
                    if (MODE == 1) { f32x4 z0, z1; unpack8(*(const GAS v4u*)(Z + r * 2048 + c), z0, z1); v0 = v0 + z0; v1 = v1 + z1; }
                    *(GAS v4u*)(Z + r * 2048 + c) = pack8(v0, v1); } }
    }
};
struct EpiMix {
    static constexpr bool PERM = true, AFTER_DRAIN = false, NOT_IDEMPOTENT = false, HAS_MID = true; static constexpr int NST = 0;
    unsigned char* ws;
    __device__ __forceinline__ void mid(pg8::f32x4 (&acc)[2][2][4][2], const pg8::Unit& u, int wr, int wc, int fr, int fq) const {
        const int row0 = u.pm * 256 + wr * 64 + fr, col0 = u.pn * 256 + wc * 32 + 8 * fq; const bf16* GT = (const bf16*)(ws + WS_GT);
        v4u cv[2][4][2];
#pragma unroll
        for (int ai = 0; ai < 2; ++ai)
#pragma unroll
            for (int m = 0; m < 4; ++m)
#pragma unroll
                for (int bj = 0; bj < 2; ++bj) cv[ai][m][bj] = *(const GAS v4u*)(GT + (size_t)(row0 + ai * 128 + m * 16) * 4096 + col0 + bj * 128);
        __builtin_amdgcn_sched_barrier(0);
#pragma unroll
        for (int ai = 0; ai < 2; ++ai)
#pragma unroll
            for (int m = 0; m < 4; ++m)
#pragma unroll
                for (int bj = 0; bj < 2; ++bj) { f32x4 c0, c1; unpack8(cv[ai][m][bj], c0, c1); acc[ai][bj][m][0] = acc[ai][bj][m][0] * c0; acc[ai][bj][m][1] = acc[ai][bj][m][1] * c1; }
        __builtin_amdgcn_sched_barrier(0);
    }
    __device__ __forceinline__ void operator()(AccRef acc, const pg8::Unit& u, int wr, int wc, int fr, int fq) const {
        const int row0 = u.pm * 256 + wr * 64 + fr, col0 = u.pn * 256 + wc * 32 + 8 * fq;
        bf16* Z = (bf16*)(ws + WS_Z); const bf16* GT = (const bf16*)(ws + WS_GT) + 2048;
#pragma unroll
        for (int ai = 0; ai < 2; ++ai) { v4u gv[4][2];
#pragma unroll
            for (int m = 0; m < 4; ++m)
#pragma unroll
                for (int bj = 0; bj < 2; ++bj) gv[m][bj] = *(const GAS v4u*)(GT + (size_t)(row0 + ai * 128 + m * 16) * 4096 + col0 + bj * 128);
            __builtin_amdgcn_sched_barrier(0);
#pragma unroll
            for (int m = 0; m < 4; ++m)
#pragma unroll
                for (int bj = 0; bj < 2; ++bj) { f32x4 g0, g1; unpack8(gv[m][bj], g0, g1);
                    *(GAS v4u*)(Z + (size_t)(row0 + ai * 128 + m * 16) * 2048 + col0 + bj * 128) = pack8(acc[ai][bj][m][0] * g0, acc[ai][bj][m][1] * g1); }
            __builtin_amdgcn_sched_barrier(0); }
    }
};
template <bool RES16, bool OUT16> struct EpiRes {
    static constexpr bool PERM = RES16 && OUT16, AFTER_DRAIN = false, NOT_IDEMPOTENT = false, HAS_MID = false; static constexpr int NST = 0;
    const void* res; void* out; float scale; const float* rg;
    __device__ __forceinline__ void operator()(AccRef acc, const pg8::Unit& u, int wr, int wc, int fr, int fq) const {
      if constexpr (PERM) {
        const int row0 = u.pm * 256 + wr * 64 + fr, col0 = u.pn * 256 + wc * 32 + 8 * fq;
        f32x4 gi[2][2];
#pragma unroll
        for (int bj = 0; bj < 2; ++bj)
#pragma unroll
            for (int n = 0; n < 2; ++n) { gi[bj][n] = (f32x4){1.f, 1.f, 1.f, 1.f}; if (rg) { const f32x4 t = *(const GAS f32x4*)(rg + col0 + bj * 128 + n * 4); gi[bj][n] = (f32x4){__builtin_amdgcn_rcpf(t.x), __builtin_amdgcn_rcpf(t.y), __builtin_amdgcn_rcpf(t.z), __builtin_amdgcn_rcpf(t.w)}; } }
#pragma unroll
        for (int ai = 0; ai < 2; ++ai) { v4u rv[4][2];
#pragma unroll
            for (int m = 0; m < 4; ++m)
#pragma unroll
                for (int bj = 0; bj < 2; ++bj) rv[m][bj] = *(const GAS v4u*)((const bf16*)res + (size_t)(row0 + ai * 128 + m * 16) * 2048 + col0 + bj * 128);
            __builtin_amdgcn_sched_barrier(0);
#pragma unroll
            for (int m = 0; m < 4; ++m)
#pragma unroll
                for (int bj = 0; bj < 2; ++bj) { f32x4 r0, r1; unpack8(rv[m][bj], r0, r1);
                    *(GAS v4u*)((bf16*)out + (size_t)(row0 + ai * 128 + m * 16) * 2048 + col0 + bj * 128) = pack8(r0 * gi[bj][0] + acc[ai][bj][m][0] * scale, r1 * gi[bj][1] + acc[ai][bj][m][1] * scale); }
            __builtin_amdgcn_sched_barrier(0); }
      } else {
        const int row0 = u.pm * 256 + wr * 64 + fr, col0 = u.pn * 256 + wc * 32 + 4 * fq;
        f32x4 gi[2][2];
#pragma unroll
        for (int bj = 0; bj < 2; ++bj)
#pragma unroll
            for (int n = 0; n < 2; ++n) { gi[bj][n] = (f32x4){1.f, 1.f, 1.f, 1.f}; if (rg) { const f32x4 t = *(const GAS f32x4*)(rg + col0 + bj * 128 + n * 16); gi[bj][n] = (f32x4){1.f / t.x, 1.f / t.y, 1.f / t.z, 1.f / t.w}; } }
#pragma unroll
        for (int ai = 0; ai < 2; ++ai)
#pragma unroll
            for (int m = 0; m < 4; ++m) { const size_t o = (size_t)(row0 + ai * 128 + m * 16) * 2048 + col0;
#pragma unroll
                for (int bj = 0; bj < 2; ++bj)
#pragma unroll
                    for (int n = 0; n < 2; ++n) { const size_t oo = o + bj * 128 + n * 16; f32x4 r;
                        if constexpr (RES16) { const v2u w = *(const GAS v2u*)((const bf16*)res + oo); r = (f32x4){bflo(w.x), bfhi(w.x), bflo(w.y), bfhi(w.y)}; } else r = *(const GAS f32x4*)((const float*)res + oo);
                        const f32x4 v = r * gi[bj][n] + acc[ai][bj][m][n] * scale;
                        if constexpr (OUT16) { v2u w; w.x = pk2(v.x, v.y); w.y = pk2(v.z, v.w); *(GAS v2u*)((bf16*)out + oo) = w; } else *(GAS f32x4*)((float*)out + oo) = v; } }
      }
    }
};
template <bool F8OUT, bool RES16, bool OUT16> struct EpiRes2 {
    static constexpr bool PERM = RES16 && OUT16, AFTER_DRAIN = false, NOT_IDEMPOTENT = false, HAS_MID = false; static constexpr int NST = 0;
    const void* res; void* out; float scale; const float* g; void* Hn; float* slab; const float* rg; const float* rrow;
    __device__ __forceinline__ void operator()(AccRef acc, const pg8::Unit& u, int wr, int wc, int fr, int fq) const {
      if constexpr (PERM) {
        const int row0 = u.pm * 256 + wr * 64 + fr, col0 = u.pn * 256 + wc * 32 + 8 * fq;
        f32x4 gv[2][2], gi[2][2];
#pragma unroll
        for (int bj = 0; bj < 2; ++bj)
#pragma unroll
            for (int n = 0; n < 2; ++n) { gi[bj][n] = (f32x4){1.f, 1.f, 1.f, 1.f}; if (rg) { const f32x4 t = *(const GAS f32x4*)(rg + col0 + bj * 128 + n * 4); gi[bj][n] = (f32x4){__builtin_amdgcn_rcpf(t.x), __builtin_amdgcn_rcpf(t.y), __builtin_amdgcn_rcpf(t.z), __builtin_amdgcn_rcpf(t.w)}; }
                gv[bj][n] = *(const GAS f32x4*)(g + col0 + bj * 128 + n * 4) * (F8OUT ? F8_SA : 1.0f); }
#pragma unroll
        for (int ai = 0; ai < 2; ++ai) { v4u rv[4][2]; float rr[4];
#pragma unroll
            for (int m = 0; m < 4; ++m) { const int row = row0 + ai * 128 + m * 16; rr[m] = rrow ? rrow[row] : 1.0f;
#pragma unroll
                for (int bj = 0; bj < 2; ++bj) rv[m][bj] = *(const GAS v4u*)((const bf16*)res + (size_t)row * 2048 + col0 + bj * 128); }
            __builtin_amdgcn_sched_barrier(0);
#pragma unroll
            for (int m = 0; m < 4; ++m) { const int row = row0 + ai * 128 + m * 16; float ss = 0.f;
#pragma unroll
                for (int bj = 0; bj < 2; ++bj) { const size_t oo = (size_t)row * 2048 + col0 + bj * 128; f32x4 r0, r1; unpack8(rv[m][bj], r0, r1);
                    const f32x4 v0 = r0 * gi[bj][0] * rr[m] + acc[ai][bj][m][0] * scale, v1 = r1 * gi[bj][1] * rr[m] + acc[ai][bj][m][1] * scale;
                    if (out) *(GAS v4u*)((bf16*)out + oo) = pack8(v0, v1);
                    ss += ((v0.x * v0.x + v0.y * v0.y) + (v0.z * v0.z + v0.w * v0.w)) + ((v1.x * v1.x + v1.y * v1.y) + (v1.z * v1.z + v1.w * v1.w));
                    const f32x4 h0 = v0 * gv[bj][0], h1 = v1 * gv[bj][1];
                    if constexpr (F8OUT) { v2u w; w.x = pk4_fp8(h0.x, h0.y, h0.z, h0.w); w.y = pk4_fp8(h1.x, h1.y, h1.z, h1.w); *(GAS v2u*)((unsigned char*)Hn + oo) = w; }
                    else *(GAS v4u*)((bf16*)Hn + oo) = pack8(h0, h1); }
                ss += __shfl_xor(ss, 16); ss += __shfl_xor(ss, 32);
                if (fq == 0) slab[(size_t)(u.pn * 4 + wc) * NTOK + row] = ss; }
            __builtin_amdgcn_sched_barrier(0); }
      } else {
        const int row0 = u.pm * 256 + wr * 64 + fr, col0 = u.pn * 256 + wc * 32 + 4 * fq;
        f32x4 gv[2][2], gi[2][2];
#pragma unroll
        for (int bj = 0; bj < 2; ++bj)
#pragma unroll
            for (int n = 0; n < 2; ++n) { gi[bj][n] = (f32x4){1.f, 1.f, 1.f, 1.f}; if (rg) { const f32x4 t = *(const GAS f32x4*)(rg + col0 + bj * 128 + n * 16); gi[bj][n] = (f32x4){1.f / t.x, 1.f / t.y, 1.f / t.z, 1.f / t.w}; } }
#pragma unroll
        for (int bj = 0; bj < 2; ++bj)
#pragma unroll
            for (int n = 0; n < 2; ++n) gv[bj][n] = *(const GAS f32x4*)(g + col0 + bj * 128 + n * 16) * (F8OUT ? F8_SA : 1.0f);
#pragma unroll
        for (int ai = 0; ai < 2; ++ai)
#pragma unroll
            for (int m = 0; m < 4; ++m) { const int row = row0 + ai * 128 + m * 16; const size_t o = (size_t)row * 2048 + col0; float ss = 0.f; const float rr = rrow ? rrow[row] : 1.0f;
#pragma unroll
                for (int bj = 0; bj < 2; ++bj)
#pragma unroll
                    for (int n = 0; n < 2; ++n) { const size_t oo = o + bj * 128 + n * 16; f32x4 r;
                        if constexpr (RES16) { const v2u w = *(const GAS v2u*)((const bf16*)res + oo); r = (f32x4){bflo(w.x), bfhi(w.x), bflo(w.y), bfhi(w.y)}; } else r = *(const GAS f32x4*)((const float*)res + oo);
                        const f32x4 v = r * gi[bj][n] * rr + acc[ai][bj][m][n] * scale;
                        if (out) { if constexpr (OUT16) { v2u w; w.x = pk2(v.x, v.y); w.y = pk2(v.z, v.w); *(GAS v2u*)((bf16*)out + oo) = w; } else *(GAS f32x4*)((float*)out + oo) = v; }
                        ss += (v.x * v.x + v.y * v.y) + (v.z * v.z + v.w * v.w);
                        const f32x4 h = v * gv[bj][n];
                        if constexpr (F8OUT) *(GAS unsigned*)((unsigned char*)Hn + oo) = pk4_fp8(h.x, h.y, h.z, h.w);
                        else { v2u w; w.x = pk2(h.x, h.y); w.y = pk2(h.z, h.w); *(GAS v2u*)((bf16*)Hn + oo) = w; } }
                ss += __shfl_xor(ss, 16); ss += __shfl_xor(ss, 32);
                if (fq == 0) slab[(size_t)(u.pn * 4 + wc) * NTOK + row] = ss; }
      }
    }
};
__device__ __forceinline__ int fixed_panel(int c) { return 8 * (c & 7) + ((c >> 3) & 7); }
__device__ __forceinline__ void rstd_table(const Frame& F, const float* slab, int pm) {
    LAS float* tab = (LAS float*)(F.lds + RSTD_OFF);
    if (F.tid < 256) { const GAS float* p = (const GAS float*)slab + (size_t)pm * 256 + F.tid; float s = 0.f;
#pragma unroll
        for (int k = 0; k < 32; ++k) s += p[(size_t)k * NTOK];
        tab[F.tid] = 1.0f / sqrtf(s * (1.f / D) + RMS_EPS); }
    __syncthreads();
}
struct EpiSwiglu {
    static constexpr bool PERM = true, AFTER_DRAIN = false, NOT_IDEMPOTENT = false, HAS_MID = false; static constexpr int NST = 0;
    bf16* out; int ldc, ntile;
    __device__ __forceinline__ void operator()(AccRef acc, const pg8::Unit& u, int wr, int wc, int fr, int fq) const {
        const int row0 = u.pm * 256 + wr * 64 + fr, col0 = (u.pn % ntile) * 128 + wc * 32 + 8 * fq;
#pragma unroll
        for (int ai = 0; ai < 2; ++ai)
#pragma unroll
            for (int m = 0; m < 4; ++m) { f32x4 v0, v1;
#pragma unroll
                for (int j = 0; j < 4; ++j) { v0[j] = siluf_(acc[ai][0][m][0][j]) * acc[ai][1][m][0][j]; v1[j] = siluf_(acc[ai][0][m][1][j]) * acc[ai][1][m][1][j]; }
                *(GAS v4u*)(out + (size_t)(row0 + ai * 128 + m * 16) * ldc + col0) = pack8(v0, v1); }
    }
};
struct EpiSwigluF8 {
    static constexpr bool PERM = true, AFTER_DRAIN = false, NOT_IDEMPOTENT = false, HAS_MID = false; static constexpr int NST = 0;
    unsigned char* out; int ldc, ntile; const LAS float* rstd; int use_aux;
    __device__ __forceinline__ void operator()(AccRef acc, const pg8::Unit& u, int wr, int wc, int fr, int fq) const {
        const int row0 = (use_aux ? u.aux : u.pm) * 256 + wr * 64 + fr, col0 = (u.pn % ntile) * 128 + wc * 32 + 8 * fq; const float si0 = 1.0f / (F8_SA * F8_SW);
#pragma unroll
        for (int ai = 0; ai < 2; ++ai)
#pragma unroll
            for (int m = 0; m < 4; ++m) { float v[8]; const float si = rstd ? si0 * rstd[ai * 128 + wr * 64 + m * 16 + fr] : si0;
                const float c1 = -1.4426950408889634f * si, k2 = si * si * F8_SACT;
#pragma unroll
                for (int n = 0; n < 2; ++n)
#pragma unroll
                    for (int jj = 0; jj < 2; ++jj) { const f32x2 a = {acc[ai][0][m][n][2 * jj], acc[ai][0][m][n][2 * jj + 1]}, b = {acc[ai][1][m][n][2 * jj], acc[ai][1][m][n][2 * jj + 1]};
                        const f32x2 t = a * c1; f32x2 d = {fast_exp2(t.x), fast_exp2(t.y)}; d = d + 1.0f; const f32x2 r = {__builtin_amdgcn_rcpf(d.x), __builtin_amdgcn_rcpf(d.y)};
                        const f32x2 vv = ((a * b) * k2) * r; v[4 * n + 2 * jj] = vv.x; v[4 * n + 2 * jj + 1] = vv.y; }
                v2u o; o.x = pk4_fp8(v[0], v[1], v[2], v[3]); o.y = pk4_fp8(v[4], v[5], v[6], v[7]);
                *(GAS v2u*)(out + (size_t)(row0 + ai * 128 + m * 16) * ldc + col0) = o; }
    }
};
struct EpiPartial {
    static constexpr bool PERM = true, AFTER_DRAIN = false, NOT_IDEMPOTENT = false, HAS_MID = false; static constexpr int NST = 0;
    float* part;
    __device__ __forceinline__ void operator()(AccRef acc, const pg8::Unit&, int wr, int wc, int fr, int fq) const {
        const int row0 = wr * 64 + fr, col0 = wc * 32 + 8 * fq;
#pragma unroll
        for (int ai = 0; ai < 2; ++ai)
#pragma unroll
            for (int m = 0; m < 4; ++m) { float* rp = part + (size_t)(row0 + ai * 128 + m * 16) * 256 + col0;
#pragma unroll
                for (int bj = 0; bj < 2; ++bj) { *(GAS f32x4*)(rp + bj * 128) = acc[ai][bj][m][0]; *(GAS f32x4*)(rp + bj * 128 + 4) = acc[ai][bj][m][1]; } }
    }
};
struct EpiMoeDown {
    static constexpr bool PERM = true, AFTER_DRAIN = false, NOT_IDEMPOTENT = false, HAS_MID = false; static constexpr int NST = 0;
    unsigned char* ws;
    __device__ __forceinline__ void operator()(AccRef acc, const pg8::Unit& u, int wr, int wc, int fr, int fq) const {
        const int row0 = u.aux * 256 + wr * 64 + fr, col0 = (u.pn & 7) * 256 + wc * 32 + 8 * fq;
        const int* rowtok = (const int*)(ws + WS_ROWTOK); const float* roww = (const float*)(ws + WS_ROWW); bf16* Y = (bf16*)(ws + WS_XB);
        int tk[2][4]; float w[2][4];
#pragma unroll
        for (int ai = 0; ai < 2; ++ai)
#pragma unroll
            for (int m = 0; m < 4; ++m) { const int r = row0 + ai * 128 + m * 16; tk[ai][m] = rowtok[r]; w[ai][m] = roww[r]; }
        __builtin_amdgcn_sched_barrier(0);
#pragma unroll
        for (int ai = 0; ai < 2; ++ai)
#pragma unroll
            for (int m = 0; m < 4; ++m) { const float ws_ = w[ai][m] * (1.0f / (F8_SACT * F8_SW));
                if (tk[ai][m] >= 0) {
#pragma unroll
                    for (int bj = 0; bj < 2; ++bj) *(GAS v4u*)(Y + (size_t)tk[ai][m] * 2048 + col0 + bj * 128) = pack8(acc[ai][bj][m][0] * ws_, acc[ai][bj][m][1] * ws_); } }
    }
};

template <int MAP> __device__ __forceinline__ int map_row(int n) {
    if (MAP == 0) return n;
    if (MAP == 1) { if (n < 5632) return n; if (n < 5696) return n + (9728 - 5632); if (n < 5712) return n + (9792 - 5696);
        const int ng = n - 5712, br = ng >> 11, ch = ng & 2047; return 5632 + (ch >> 7) * 256 + br * 128 + (ch & 127); }
    if (MAP == 2) return (n >> 7) * 256 + (n & 127);
    return (n >> 7) * 256 + 128 + (n & 127);
}
__device__ __forceinline__ float rms_row(const float* xrow, const float* g, bf16* orow, int lane, f32x4 (&v)[8]) {
    const GAS f32x4* xr = (const GAS f32x4*)xrow + lane; float s = 0.f;
#pragma unroll
    for (int j = 0; j < 8; ++j) { v[j] = xr[64 * j]; s += (v[j].x * v[j].x + v[j].y * v[j].y) + (v[j].z * v[j].z + v[j].w * v[j].w); }
    const float rstd = 1.0f / sqrtf(wave_sum(s) * (1.f / D) + RMS_EPS);
    const GAS f32x4* gr = (const GAS f32x4*)g + lane; GAS v2u* o8 = (GAS v2u*)orow + lane;
#pragma unroll
    for (int j = 0; j < 8; ++j) { v[j] = v[j] * rstd * gr[64 * j]; v2u o; o.x = pk2(v[j].x, v[j].y); o.y = pk2(v[j].z, v[j].w); o8[64 * j] = o; }
    return rstd;
}
__device__ __forceinline__ void rms_pass_f8(const Frame& F, const float* x, const float* g, unsigned char* H) {
    const int gw = F.vcu * NWAVES + F.wave, NGW = F.G * NWAVES, lane = F.lane;
    for (int m = gw; m < NTOK; m += NGW) {
        const GAS f32x4* xr = (const GAS f32x4*)(x + (size_t)m * D) + lane; f32x4 v[8]; float s = 0.f;
#pragma unroll
        for (int j = 0; j < 8; ++j) { v[j] = xr[64 * j]; s += (v[j].x * v[j].x + v[j].y * v[j].y) + (v[j].z * v[j].z + v[j].w * v[j].w); }
        const float rstd = F8_SA / sqrtf(wave_sum(s) * (1.f / D) + RMS_EPS);
        const GAS f32x4* gr = (const GAS f32x4*)g + lane; GAS unsigned* o4 = (GAS unsigned*)(H + (size_t)m * D) + lane;
#pragma unroll
        for (int j = 0; j < 8; ++j) { const f32x4 t = v[j] * rstd * gr[64 * j]; o4[64 * j] = pk4_fp8(t.x, t.y, t.z, t.w); }
    }
}
__device__ __forceinline__ void rms_pass(const Frame& F, const float* x, const float* g, bf16* H, float* rms_out = nullptr) {
    const int gw = F.vcu * NWAVES + F.wave, NGW = F.G * NWAVES; f32x4 v[8];
    for (int m = gw; m < NTOK; m += NGW) { const float rstd = rms_row(x + (size_t)m * D, g, H + (size_t)m * D, F.lane, v); if (rms_out && F.lane == 0) rms_out[m] = 1.0f / rstd; }
}
#define CAS __attribute__((address_space(4)))
struct CvtItem { const float* W; unsigned char* WT; int K, N, k0, n0, map, f8, ldk; };
constexpr int I_IN = 32 * 154, I_C = 16 * 32, I_O = 32 * 32, I_F1 = 32 * 88, I_F2 = 88 * 32, I_E1 = 32 * 112, I_E2 = 112 * 32;
constexpr int CB0 = 0, CB1 = CB0 + 2 * I_IN, CB2 = CB1 + 2 * I_C, CB3 = CB2 + 2 * I_C, CB4 = CB3 + 2 * I_O, CB5 = CB4 + I_F1, CB6 = CB5 + I_F1, CB7 = CB6 + I_F2,
              CB8 = CB7 + 8 * I_E1, CB9 = CB8 + 8 * I_E1, CB10 = CB9 + 8 * I_E2;
constexpr int CBX = CB7 + (int)((long)(CB10 - CB7) * CONV_PROLOGUE_PCT / 100), CBS2 = CB10 - (int)((long)(CB10 - CB7) * CONV_S2_PCT / 100), CBS1 = CBS2 - (int)((long)(CB10 - CB7) * CONV_S1_PCT / 100);
__device__ __forceinline__ CvtItem cvt_decode(const CAS Args* ap, unsigned char* ws, int it) {
    CvtItem d; int item;
    if (it >= CB9) { const int r = it - CB9, e = r / I_E2; d.W = ap->in[14] + (size_t)e * FFE * D; d.K = FFE; d.N = D; d.WT = ws + WS_EW2 + (size_t)e * D * FFE; d.map = 0; d.f8 = 1; item = r - e * I_E2; }
    else if (it >= CB8) { const int r = it - CB8, e = r / I_E1; d.W = ap->in[13] + (size_t)e * D * FFE; d.K = D; d.N = FFE; d.WT = ws + WS_EW13 + (size_t)e * 2 * FFE * D; d.map = 3; d.f8 = 1; item = r - e * I_E1; }
    else if (it >= CB7) { const int r = it - CB7, e = r / I_E1; d.W = ap->in[12] + (size_t)e * D * FFE; d.K = D; d.N = FFE; d.WT = ws + WS_EW13 + (size_t)e * 2 * FFE * D; d.map = 2; d.f8 = 1; item = r - e * I_E1; }
    else if (it >= CB6) { d.W = ap->in[10]; d.K = FF; d.N = D; d.WT = ws + WS_W2; d.map = 0; d.f8 = F8_FFN; item = it - CB6; }
    else if (it >= CB5) { d.W = ap->in[9]; d.K = D; d.N = FF; d.WT = ws + WS_W13; d.map = 3; d.f8 = F8_FFN; item = it - CB5; }
    else if (it >= CB4) { d.W = ap->in[8]; d.K = D; d.N = FF; d.WT = ws + WS_W13; d.map = 2; d.f8 = F8_FFN; item = it - CB4; }
    else if (it >= CB3) { const int r = it - CB3, l = r / I_O; d.W = ap->in[6] + (size_t)l * D * D; d.K = D; d.N = D; d.WT = ws + WS_WO + (size_t)l * D * D * 2; d.map = 0; d.f8 = 0; item = r - l * I_O; }
    else if (it >= CB2) { const int r = it - CB2, l = r / I_C; d.W = ap->in[5] + (size_t)l * 1024 * D; d.K = 1024; d.N = D; d.WT = ws + WS_WC + (size_t)l * D * D * 2 + 1024 * 2; d.map = 0; d.f8 = 0; item = r - l * I_C; }
    else if (it >= CB1) { const int r = it - CB1, l = r / I_C; d.W = ap->in[4] + (size_t)l * 1024 * D; d.K = 1024; d.N = D; d.WT = ws + WS_WC + (size_t)l * D * D * 2; d.map = 0; d.f8 = 0; item = r - l * I_C; }
    else { const int l = it / I_IN; d.W = ap->in[2] + (size_t)l * D * INC; d.K = D; d.N = INC; d.WT = ws + (l ? WS_W1 : WS_W0); d.map = 1; d.f8 = 0; item = it - l * I_IN; }
    const int nblk = (d.N + 63) >> 6, kb = item / nblk, nb = item - kb * nblk; d.k0 = 64 * kb; d.n0 = 64 * nb;
    d.ldk = (it >= CB1 && it < CB3) ? 2048 : d.K;
    return d;
}
__device__ __forceinline__ int map_row_rt(int map, int n) { return map == 0 ? n : (map == 1 ? map_row<1>(n) : (map == 2 ? map_row<2>(n) : map_row<3>(n))); }
__device__ __forceinline__ void cvt_load(const CvtItem& d, f32x4 (&v)[16], int lane) {
    const int r = lane >> 4, q = lane & 15; const bool ld_ok = (d.n0 + 4 * q) < d.N;
    const GAS float* p = (const GAS float*)d.W + (size_t)(d.k0 + r) * d.N + d.n0 + 4 * q;
#pragma unroll
    for (int i = 0; i < 16; ++i) v[i] = ld_ok ? __builtin_nontemporal_load((const GAS f32x4*)(p + (size_t)(4 * i) * d.N)) : (f32x4){0.f, 0.f, 0.f, 0.f};
}
__device__ __forceinline__ void cvt_store(const CvtItem& d, f32x4 (&v)[16], LAS unsigned char* scr, int lane) {
#pragma unroll
    for (int i = 0; i < 16; ++i) {
        const float f0 = v[i][0], f1 = v[i][1], f2 = v[i][2], f3 = v[i][3];
        unsigned a0 = __builtin_bit_cast(unsigned, f0), a1 = __builtin_bit_cast(unsigned, f1), a2 = __builtin_bit_cast(unsigned, f2), a3 = __builtin_bit_cast(unsigned, f3);
        { auto t = __builtin_amdgcn_permlane16_swap(a0, a1, false, false); a0 = t[0]; a1 = t[1]; }
        { auto t = __builtin_amdgcn_permlane16_swap(a2, a3, false, false); a2 = t[0]; a3 = t[1]; }
        { auto t = __builtin_amdgcn_permlane32_swap(a0, a2, false, false); a0 = t[0]; a2 = t[1]; }
        { auto t = __builtin_amdgcn_permlane32_swap(a1, a3, false, false); a1 = t[0]; a3 = t[1]; }
        v[i] = (f32x4){__builtin_bit_cast(float, a0), __builtin_bit_cast(float, a1), __builtin_bit_cast(float, a2), __builtin_bit_cast(float, a3)};
    }
    LAS unsigned char* my = scr + lane * 144;
    if (d.f8) {
#pragma unroll
        for (int p = 0; p < 4; ++p) { v4u o; o.x = pk4_fp8(v[4 * p][0] * F8_SW, v[4 * p][1] * F8_SW, v[4 * p][2] * F8_SW, v[4 * p][3] * F8_SW); o.y = pk4_fp8(v[4 * p + 1][0] * F8_SW, v[4 * p + 1][1] * F8_SW, v[4 * p + 1][2] * F8_SW, v[4 * p + 1][3] * F8_SW);
            o.z = pk4_fp8(v[4 * p + 2][0] * F8_SW, v[4 * p + 2][1] * F8_SW, v[4 * p + 2][2] * F8_SW, v[4 * p + 2][3] * F8_SW); o.w = pk4_fp8(v[4 * p + 3][0] * F8_SW, v[4 * p + 3][1] * F8_SW, v[4 * p + 3][2] * F8_SW, v[4 * p + 3][3] * F8_SW); *(LAS v4u*)(my + 16 * p) = o; }
        LDS_WAIT(); asm volatile("" ::: "memory");
#pragma unroll
        for (int jj = 0; jj < 4; ++jj) { const int s_ = 16 * jj + (lane >> 2), c = lane & 3, n = d.n0 + 4 * (s_ & 15) + (s_ >> 4);
            const v4u o = *(const LAS v4u*)(scr + s_ * 144 + 16 * c);
            if (n < d.N) __builtin_nontemporal_store(o, (GAS v4u*)(d.WT + (size_t)map_row_rt(d.map, n) * d.ldk + d.k0 + 16 * c)); }
    } else {
#pragma unroll
        for (int p = 0; p < 8; ++p) *(LAS v4u*)(my + 16 * p) = pack8(v[2 * p], v[2 * p + 1]);
        LDS_WAIT(); asm volatile("" ::: "memory");
#pragma unroll
        for (int jj = 0; jj < 8; ++jj) { const int s_ = 8 * jj + (lane >> 3), c = lane & 7, n = d.n0 + 4 * (s_ & 15) + (s_ >> 4);
            const v4u o = *(const LAS v4u*)(scr + s_ * 144 + 16 * c);
            if (n < d.N) __builtin_nontemporal_store(o, (GAS v4u*)(d.WT + ((size_t)map_row_rt(d.map, n) * d.ldk + d.k0 + 8 * c) * 2)); }
    }
    LDS_WAIT(); asm volatile("" ::: "memory");
}
__device__ __forceinline__ void convert_items(const Frame& F, const CAS Args* ap, int gw, int NGW, int it_lo, int it_hi) {
    unsigned char* ws = F.ws; LAS unsigned char* scr = F.lds + F.wave * 16384; const int lane = F.lane;
    int it = it_lo + gw; if (it >= it_hi) return;
    f32x4 va[16], vb[16];
    CvtItem da = cvt_decode(ap, ws, it), db = da; cvt_load(da, va, lane);
    for (;;) {
        const int it1 = it + NGW; const bool has1 = it1 < it_hi;
        if (has1) { db = cvt_decode(ap, ws, it1); cvt_load(db, vb, lane); }
        cvt_store(da, va, scr, lane);
        if (!has1) break;
        const int it2 = it1 + NGW; const bool has2 = it2 < it_hi;
        if (has2) { da = cvt_decode(ap, ws, it2); cvt_load(da, va, lane); }
        cvt_store(db, vb, scr, lane);
        if (!has2) break;
        it = it2;
    }
}
__device__ __forceinline__ void prologue(const Frame& F, const CAS Args* ap) {
    const int gw = F.vcu * NWAVES + F.wave, NGW = F.G * NWAVES;
    unsigned char* ws = F.ws;
    convert_items(F, ap, gw, NGW, 0, (NCONV > 0 && F.G == 256) ? CBX : CB10);
    { const int gt = (F.vcu * NTHR + F.tid), NT = F.G * NTHR; constexpr int PADV = (INP - INC) * D * 2 / 16;
      for (int i = gt; i < 2 * PADV; i += NT) { const int l = i / PADV, r = i - l * PADV; ((GAS v4u*)(ws + (l ? WS_W1 : WS_W0) + (size_t)INC * D * 2))[r] = (v4u){0u, 0u, 0u, 0u}; } }
    { int* rowtok = (int*)(ws + WS_ROWTOK); for (int i = F.vcu * NTHR + F.tid; i < 8 * ECAP; i += F.G * NTHR) rowtok[i] = -1; }
    rms_pass(F, ap->in[0], ap->in[1], (bf16*)(ws + WS_H), (float*)(ws + WS_RMS0));
}

__device__ __forceinline__ void conv_phase(const Frame& F, const float* convw  , int rank, int nwg) {
    const bf16* BCU = (const bf16*)(F.ws + WS_BCU); bf16* Y = (bf16*)(F.ws + WS_YMIX);
    for (int it = rank * NTHR + F.tid; it < (NTOK / 16) * 128; it += nwg * NTHR) {
        const int chunk = it & 127, t0 = (it >> 7) * 16, ch0 = chunk * 8;
        f32x4 w0a = *(const GAS f32x4*)(convw + ch0), w0b = *(const GAS f32x4*)(convw + ch0 + 4);
        f32x4 w1a = *(const GAS f32x4*)(convw + 1024 + ch0), w1b = *(const GAS f32x4*)(convw + 1024 + ch0 + 4);
        f32x4 w2a = *(const GAS f32x4*)(convw + 2048 + ch0), w2b = *(const GAS f32x4*)(convw + 2048 + ch0 + 4);
        f32x4 p2a = {0.f, 0.f, 0.f, 0.f}, p2b = p2a, p1a = p2a, p1b = p2a;
        if ((t0 & (T - 1)) != 0) {
            f32x4 ca, cb, ua, ub;
            unpack8(*(const GAS v4u*)(BCU + (size_t)(t0 - 2) * 3072 + 1024 + ch0), ca, cb); unpack8(*(const GAS v4u*)(BCU + (size_t)(t0 - 2) * 3072 + 2048 + ch0), ua, ub); p2a = ca * ua; p2b = cb * ub;
            unpack8(*(const GAS v4u*)(BCU + (size_t)(t0 - 1) * 3072 + 1024 + ch0), ca, cb); unpack8(*(const GAS v4u*)(BCU + (size_t)(t0 - 1) * 3072 + 2048 + ch0), ua, ub); p1a = ca * ua; p1b = cb * ub;
        }
#pragma unroll
        for (int hb = 0; hb < 2; ++hb) { v4u lb[8], lc[8], lu[8];
#pragma unroll
            for (int i = 0; i < 8; ++i) { const size_t r = (size_t)(t0 + hb * 8 + i) * 3072; lb[i] = *(const GAS v4u*)(BCU + r + ch0); lc[i] = *(const GAS v4u*)(BCU + r + 1024 + ch0); lu[i] = *(const GAS v4u*)(BCU + r + 2048 + ch0); }
            __builtin_amdgcn_sched_barrier(0);
#pragma unroll
            for (int i = 0; i < 8; ++i) { f32x4 ba, bb, ca, cb, ua, ub;
                unpack8(lb[i], ba, bb); unpack8(lc[i], ca, cb); unpack8(lu[i], ua, ub);
                const f32x4 va = ca * ua, vb = cb * ub;
                const f32x4 ya = ba * (w0a * p2a + w1a * p1a + w2a * va), yb = bb * (w0b * p2b + w1b * p1b + w2b * vb);
                *(GAS v4u*)(Y + (size_t)(t0 + hb * 8 + i) * 2048 + ch0) = pack8(ya, yb);
                p2a = p1a; p2b = p1b; p1a = va; p1b = vb; }
            __builtin_amdgcn_sched_barrier(0); }
    }
}

constexpr int IX_BUF = 128 * 128, IX_RING = 4;
#define GLDS16(sbase, vo, ldsaddr) asm volatile("s_mov_b32 m0, %2\n\ts_nop 0\n\tglobal_load_lds_dwordx4 %0, %1" :: "v"(vo), "s"(sbase), "s"(ldsaddr) : "memory")
#define dpp_i(x, ctrl) __builtin_amdgcn_mov_dpp((x), (ctrl), 0xF, 0xF, true)
__device__ __forceinline__ int half_sum(int x, int lane) {
    x += dpp_i(x, 0xB1); x += dpp_i(x, 0x4E); x += dpp_i(x, 0x141); x += dpp_i(x, 0x140);
    auto t = __builtin_amdgcn_permlane16_swap((unsigned)x, (unsigned)x, false, false); return x + (int)(((lane >> 4) & 1) ? t[0] : t[1]);
}
__device__ __forceinline__ unsigned half_umax(unsigned x, int lane) {
    unsigned y;
    y = (unsigned)dpp_i((int)x, 0xB1); x = x > y ? x : y; y = (unsigned)dpp_i((int)x, 0x4E); x = x > y ? x : y; y = (unsigned)dpp_i((int)x, 0x141); x = x > y ? x : y; y = (unsigned)dpp_i((int)x, 0x140); x = x > y ? x : y;
    auto t = __builtin_amdgcn_permlane16_swap(x, x, false, false); y = ((lane >> 4) & 1) ? t[0] : t[1]; return x > y ? x : y;
}
__device__ __forceinline__ void indexer_unit(const Frame& F, int b, int tg) {
    LAS unsigned char* lds = F.lds;
    const int lane = F.lane, c = lane & 31, hi = lane >> 5, tid = F.tid;
    const int tA = tg * 16 + 2 * F.wave, tme = tA + hi;
    const int ntile = ((tA + 1) >> 5) + 1;
    const int nchunk = ((tg * 16 + 15) >> 7) + 1;
    const bf16* QI = (const bf16*)(F.ws + WS_QI); const bf16* KW = (const bf16*)(F.ws + WS_KW);
    const int atok = tA + ((c >> 2) & 1), ahead = (c >> 3) * 4 + (c & 3);
    const GAS bf16x8* qp = (const GAS bf16x8*)(QI + ((size_t)(b * T + atok) * 1024 + ahead * 64 + 8 * hi));
    bf16x8 qa[4];
#pragma unroll
    for (int kk = 0; kk < 4; ++kk) qa[kk] = qp[2 * kk];
    float w[16];
    { const GAS v4u* wp = (const GAS v4u*)(KW + (size_t)(b * T + tme) * 256 + 64); const v4u w0 = wp[0], w1 = wp[1];
      w[0] = bflo(w0.x); w[1] = bfhi(w0.x); w[2] = bflo(w0.y); w[3] = bfhi(w0.y); w[4] = bflo(w0.z); w[5] = bfhi(w0.z); w[6] = bflo(w0.w); w[7] = bfhi(w0.w);
      w[8] = bflo(w1.x); w[9] = bfhi(w1.x); w[10] = bflo(w1.y); w[11] = bfhi(w1.y); w[12] = bflo(w1.z); w[13] = bfhi(w1.z); w[14] = bflo(w1.w); w[15] = bfhi(w1.w); }
    const int wv = F.wave;
    unsigned dvo[2];
#pragma unroll
    for (int jj = 0; jj < 2; ++jj) { const int row = (wv * 2 + jj) * 8 + (lane >> 3), slot = lane & 7; dvo[jj] = (unsigned)((row * 256 + ((slot ^ ((row >> 1) & 7)) * 8)) * 2); }
    const char* kbase = (const char*)(KW + (size_t)(b * T) * 256);
    const unsigned ldsb = (unsigned)__builtin_amdgcn_readfirstlane((int)((unsigned)(size_t)lds + (unsigned)wv * 2048u));
#define IX_ISSUE(chn) do { const char* sb_ = kbase + (size_t)(chn) * 128 * 512; const unsigned la_ = ldsb + (unsigned)(((chn) % IX_RING) * IX_BUF); \
        GLDS16(sb_, dvo[0], la_); GLDS16(sb_, dvo[1], la_ + 1024u); } while (0)
    int roff[4];
#pragma unroll
    for (int kk = 0; kk < 4; ++kk) roff[kk] = c * 128 + (((2 * kk + hi) ^ ((c >> 1) & 7)) << 4);
    unsigned S[64];
    int dcm = tme - c; asm volatile("" : "+v"(dcm));
    const unsigned UNEG = 0x007FFFFFu;
    unsigned umax = UNEG;
    __syncthreads();
#pragma unroll
    for (int p = 0; p < IX_RING - 1; ++p) if (p < nchunk) IX_ISSUE(p);
#pragma unroll
    for (int ch = 0; ch < 16; ++ch) {
        if (ch < nchunk) {
            if (ch + IX_RING - 2 < nchunk) asm volatile("s_waitcnt vmcnt(%0)" :: "n"(2 * (IX_RING - 2)) : "memory"); else asm volatile("s_waitcnt vmcnt(0)" ::: "memory");
            __syncthreads();
            if (ch + IX_RING - 1 < nchunk) IX_ISSUE(ch + IX_RING - 1);
            LAS unsigned char* buf = lds + (ch % IX_RING) * IX_BUF;
#pragma unroll
            for (int i = 0; i < 4; ++i) { const int jt = ch * 4 + i;
                unsigned uk = UNEG;
                if (jt < ntile) {
                    bf16x8 kq[4];
#pragma unroll
                    for (int kk = 0; kk < 4; ++kk) kq[kk] = *(const LAS bf16x8*)(buf + roff[kk] + i * 32 * 128);
                    f32x16 acc;
#pragma unroll
                    for (int r = 0; r < 16; ++r) acc[r] = 0.f;
#pragma unroll
                    for (int kk = 0; kk < 4; ++kk) acc = __builtin_amdgcn_mfma_f32_32x32x16_bf16(qa[kk], kq[kk], acc, 0, 0, 0);
                    float ss = 0.f;
#pragma unroll
                    for (int r = 0; r < 16; ++r) ss = fmaf(w[r], fmaxf(acc[r], 0.f), ss);
                    const unsigned bits = __builtin_bit_cast(unsigned, ss);
                    const unsigned k2 = bits ^ (((int)bits < 0) ? 0xFFFFFFFFu : 0x80000000u);
                    uk = (32 * jt > dcm) ? UNEG : k2;
                    umax = uk > umax ? uk : umax;
                }
                S[jt] = uk; }
        } else {
#pragma unroll
            for (int i = 0; i < 4; ++i) S[ch * 4 + i] = UNEG;
        }
    }
#undef IX_ISSUE
    unsigned lo = 0x00800000u, hi_ = half_umax(umax, lane) + 1u;
    bool active = (tme + 1) > TOPK;
    for (int it = 0; it < 34; ++it) {
        if (__ballot(active) == 0ull) break;
        const unsigned mid = lo + ((hi_ - lo) >> 1);
        int cnt = 0; int nt2 = ntile; asm volatile("" : "+s"(nt2));
#pragma unroll
        for (int g = 0; g < 8; ++g)
            if (g * 8 < nt2) {
#pragma unroll
                for (int i = 0; i < 8; ++i) cnt += (S[g * 8 + i] >= mid) ? 1 : 0; }
        cnt = half_sum(cnt, lane);
        if (active) { if (cnt >= TOPK) lo = mid; else hi_ = mid; if (cnt == TOPK || hi_ - lo <= 1u) active = false; }
    }
    unsigned mA = 0u, mB = 0u;
#pragma unroll
    for (int g = 0; g < 8; ++g)
        if (g * 8 < ntile) {
#pragma unroll
            for (int i = 0; i < 8; ++i) { const int jt = g * 8 + i; const unsigned long long bal = __ballot(S[jt] >= lo);
                const unsigned blo = (unsigned)bal, bhi = (unsigned)(bal >> 32);
                asm("s_nop 3\n\tv_writelane_b32 %0, %2, %4\n\tv_writelane_b32 %1, %3, %4" : "+v"(mA), "+v"(mB) : "s"(blo), "s"(bhi), "i"(jt)); }
            __builtin_amdgcn_sched_barrier(0); }
    GAS unsigned* MK = (GAS unsigned*)(F.ws + WS_MASK);
    MK[(size_t)(b * T + tA) * 64 + lane] = mA; MK[(size_t)(b * T + tA + 1) * 64 + lane] = mB;
}
__device__ __forceinline__ int wq_next(const Frame& F, gu32* head, int limit) {
    LAS int* slot = (LAS int*)(F.lds + QSLOT_OFF);
    __syncthreads();
    if (F.tid == 0) *slot = (int)__hip_atomic_fetch_add(head, 1u, RLX_AGENT);
    __syncthreads();
    const int u = __builtin_amdgcn_readfirstlane(*slot); return u < limit ? u : -1;
}
__device__ __forceinline__ void indexer_phase(const Frame& F, bool dyn, gu32* head, int v0) {
    int v = v0, k = 0;
#pragma unroll 1
    for (;;) { int b, tg;
        if (dyn) { const int u = wq_next(F, head, 1024); if (u < 0) break; b = u & 7; tg = 127 - (u >> 3); }
        else { if (k == 4) { k = 0; v += F.G; } if (v >= 256) break; const int j = v >> 3; b = v & 7; tg = (k & 2 ? 64 : 0) + ((k & 1) ? 63 - j : j); ++k; }
        indexer_unit(F, b, tg); }
}

constexpr int AT_KROW = 272, AT_VROW = 144, AT_KBYTES = 64 * AT_KROW, AT_BUF = AT_KBYTES + 128 * AT_VROW;
__device__ __forceinline__ void attn_unit(const Frame& F, int b, int g, int blk) {
    LAS unsigned char* lds = F.lds;
    const int lane = F.lane, c = lane & 31, hi = lane >> 5, w = F.wave, tid = F.tid;
    const int head = g * 4 + (w & 3), tq = blk * 64 + (w >> 2) * 32 + c;
    const bf16* Qb = (const bf16*)(F.ws + WS_Q); const bf16* Kb = (const bf16*)(F.ws + WS_K); const bf16* VT = (const bf16*)(F.ws + WS_VT);
    const GAS bf16x8* qp = (const GAS bf16x8*)(Qb + (size_t)(b * T + tq) * 1024 + head * 128 + 8 * hi);
    bf16x8 qf[8];
#pragma unroll
    for (int kk = 0; kk < 8; ++kk) qf[kk] = qp[2 * kk];
    f32x16 O[4];
#pragma unroll
    for (int d = 0; d < 4; ++d)
#pragma unroll
        for (int r = 0; r < 16; ++r) O[d][r] = 0.f;
    float m = -1e30f, l = 0.f;
    const GAS unsigned* mrow = (const GAS unsigned*)(F.ws + WS_MASK) + (size_t)(b * T + tq) * 64;
    const float C2 = 1.4426950408889634f * 0.08838834764831845f;
    const float NEG = -__builtin_inff();
    const int ntiles = blk + 1;
    const int kr0 = tid >> 4, kc0 = tid & 15, vr0 = tid >> 3, vc0 = tid & 7;
    const GAS v4u* kg = (const GAS v4u*)(Kb + (size_t)(b * T + kr0) * 256 + g * 128 + kc0 * 8);
    const GAS v4u* vg = (const GAS v4u*)(VT + (size_t)(g * 128 + vr0) * NTOK + b * T + vc0 * 8);
    v4u kreg0 = kg[0], kreg1 = kg[32 * 256 / 8], vreg0 = vg[0], vreg1 = vg[(size_t)64 * NTOK / 8];
    const int krow = (c & 19) | ((c & 4) << 1) | ((c & 8) >> 1);
    __syncthreads();
    bf16x8 pf[4];
    { const v4u z = {0u, 0u, 0u, 0u};
#pragma unroll
      for (int ks = 0; ks < 4; ++ks) pf[ks] = __builtin_bit_cast(bf16x8, z); }
    int bcur = 0, bprev = 0;
    for (int jt = 0; jt < ntiles; ++jt) {
        LAS unsigned char* kb_ = lds + bcur * AT_BUF; LAS unsigned char* vb_ = kb_ + AT_KBYTES;
        LAS unsigned char* vprev = jt == 0 ? kb_ : lds + bprev * AT_BUF + AT_KBYTES;
        *(LAS v4u*)(kb_ + kr0 * AT_KROW + kc0 * 16) = kreg0; *(LAS v4u*)(kb_ + (kr0 + 32) * AT_KROW + kc0 * 16) = kreg1;
        *(LAS v4u*)(vb_ + vr0 * AT_VROW + vc0 * 16) = vreg0; *(LAS v4u*)(vb_ + (vr0 + 64) * AT_VROW + vc0 * 16) = vreg1;
        const unsigned mw0 = mrow[2 * jt], mw1 = mrow[2 * jt + 1];
        __syncthreads();
        if (jt + 1 < ntiles) { const size_t ko = (size_t)(jt + 1) * 64 * 256 / 8, vo = (size_t)(jt + 1) * 64 / 8;
            kreg0 = kg[ko]; kreg1 = kg[ko + 32 * 256 / 8]; vreg0 = vg[vo]; vreg1 = vg[vo + (size_t)64 * NTOK / 8]; }
        f32x16 s0, s1;
#pragma unroll
        for (int r = 0; r < 16; ++r) { s0[r] = 0.f; s1[r] = 0.f; }
#pragma unroll
        for (int kk = 0; kk < 8; ++kk) {
            const bf16x8 ka = *(const LAS bf16x8*)(kb_ + krow * AT_KROW + kk * 32 + hi * 16);
            const bf16x8 kc = *(const LAS bf16x8*)(kb_ + (32 + krow) * AT_KROW + kk * 32 + hi * 16);
            s0 = __builtin_amdgcn_mfma_f32_32x32x16_bf16(ka, qf[kk], s0, 0, 0, 0);
            s1 = __builtin_amdgcn_mfma_f32_32x32x16_bf16(kc, qf[kk], s1, 0, 0, 0);
        }
        __builtin_amdgcn_sched_barrier(0);
        const unsigned m0 = mw0 >> (8 * hi), m1 = mw1 >> (8 * hi);
        float pmax = NEG;
#define AT_VFRAG(g) (*(const LAS bf16x8*)(vprev + (32 * ((g) >> 2) + c) * AT_VROW + ((g) & 3) * 32 + hi * 16))
        bf16x8 vnx = AT_VFRAG(0);
#pragma unroll
        for (int g_ = 0; g_ < 8; ++g_) {
            const bf16x8 va = vnx; vnx = AT_VFRAG(g_ + 1);
            O[g_ >> 2] = __builtin_amdgcn_mfma_f32_32x32x16_bf16(va, pf[g_ & 3], O[g_ >> 2], 0, 0, 0);
            __builtin_amdgcn_sched_barrier(0);
#pragma unroll
            for (int r = 2 * g_; r < 2 * g_ + 2; ++r) { const int bit = (r & 7) + 16 * (r >> 3);
                const unsigned k0 = (unsigned)__builtin_amdgcn_sbfe((int)m0, bit, 1), k1 = (unsigned)__builtin_amdgcn_sbfe((int)m1, bit, 1);
                const float f0 = s0[r], f1 = s1[r];
                s0[r] = __builtin_bit_cast(float, (__builtin_bit_cast(unsigned, f0) & k0) | (0xFF800000u & ~k0));
                s1[r] = __builtin_bit_cast(float, (__builtin_bit_cast(unsigned, f1) & k1) | (0xFF800000u & ~k1));
                pmax = fmaxf(pmax, fmaxf(s0[r], s1[r])); }
            __builtin_amdgcn_sched_barrier(0);
        }
        pmax = fmaxf(pmax, __shfl_xor(pmax, 32));
        const float mn = fmaxf(m, pmax), alpha = fast_exp2((m - mn) * C2), mc = mn * C2; m = mn;
        float ps = 0.f;
#pragma unroll
        for (int g_ = 8; g_ < 16; ++g_) {
            const bf16x8 va = vnx; if (g_ < 15) vnx = AT_VFRAG(g_ + 1);
            O[g_ >> 2] = __builtin_amdgcn_mfma_f32_32x32x16_bf16(va, pf[g_ & 3], O[g_ >> 2], 0, 0, 0);
            __builtin_amdgcn_sched_barrier(0);
#pragma unroll
            for (int r = 2 * (g_ - 8); r < 2 * (g_ - 8) + 2; ++r) { s0[r] = fast_exp2(fmaf(s0[r], C2, -mc)); s1[r] = fast_exp2(fmaf(s1[r], C2, -mc)); ps += s0[r] + s1[r]; }
            __builtin_amdgcn_sched_barrier(0);
        }
#undef AT_VFRAG
        l = l * alpha + ps;
        { v4u t; t.x = pk2(s0[0], s0[1]); t.y = pk2(s0[2], s0[3]); t.z = pk2(s0[4], s0[5]); t.w = pk2(s0[6], s0[7]); pf[0] = __builtin_bit_cast(bf16x8, t);
          t.x = pk2(s0[8], s0[9]); t.y = pk2(s0[10], s0[11]); t.z = pk2(s0[12], s0[13]); t.w = pk2(s0[14], s0[15]); pf[1] = __builtin_bit_cast(bf16x8, t);
          t.x = pk2(s1[0], s1[1]); t.y = pk2(s1[2], s1[3]); t.z = pk2(s1[4], s1[5]); t.w = pk2(s1[6], s1[7]); pf[2] = __builtin_bit_cast(bf16x8, t);
          t.x = pk2(s1[8], s1[9]); t.y = pk2(s1[10], s1[11]); t.z = pk2(s1[12], s1[13]); t.w = pk2(s1[14], s1[15]); pf[3] = __builtin_bit_cast(bf16x8, t); }
        __builtin_amdgcn_sched_barrier(0);
        if (__ballot(alpha != 1.0f) != 0ull) {
#pragma unroll
            for (int d = 0; d < 4; ++d)
#pragma unroll
                for (int r = 0; r < 16; ++r) O[d][r] *= alpha; }
        bprev = bcur; bcur = bcur == 2 ? 0 : bcur + 1;
    }
    { LAS unsigned char* vlast = lds + bprev * AT_BUF + AT_KBYTES;
#pragma unroll
      for (int d = 0; d < 4; ++d)
#pragma unroll
        for (int ks = 0; ks < 4; ++ks) {
            const bf16x8 va = *(const LAS bf16x8*)(vlast + (32 * d + c) * AT_VROW + ks * 32 + hi * 16);
            O[d] = __builtin_amdgcn_mfma_f32_32x32x16_bf16(va, pf[ks], O[d], 0, 0, 0); } }
    l += __shfl_xor(l, 32);
    const float inv = 1.0f / l;
    bf16* AO = (bf16*)(F.ws + WS_YMIX) + (size_t)(b * T + tq) * 2048 + 1024 + head * 128;
#pragma unroll
    for (int d = 0; d < 4; ++d)
#pragma unroll
        for (int q4 = 0; q4 < 4; ++q4) { v2u o; o.x = pk2(O[d][4 * q4] * inv, O[d][4 * q4 + 1] * inv); o.y = pk2(O[d][4 * q4 + 2] * inv, O[d][4 * q4 + 3] * inv);
            *(GAS v2u*)(AO + 32 * d + 8 * q4 + 4 * hi) = o; }
}
__device__ __forceinline__ void attn_phase(const Frame& F, bool dyn, gu32* head, int v0) {
    int v = v0, k = 0;
#pragma unroll 1
    for (;;) { int b, g, blk;
        if (dyn) { const int u = wq_next(F, head, 512); if (u < 0) break; b = u & 7; g = (u >> 3) & 1; blk = 31 - (u >> 4); }
        else { if (k == 2) { k = 0; v += F.G; } if (v >= 256) break; const int x = v >> 4; b = v & 7; g = (v >> 3) & 1; blk = k ? x : 31 - x; ++k; }
        attn_unit(F, b, g, blk); }
}

template <bool X16> __device__ __forceinline__ void router_phase(const Frame& F, const void* x, const float* g, const float* rw  ) {
    const int gw = F.vcu * NWAVES + F.wave, NGW = F.G * NWAVES, lane = F.lane;
    gu32* cnt = (gu32*)(F.ws + WS_CTL) + CW_CNT; unsigned char* XIN = (unsigned char*)(F.ws + WS_XIN); int* rowtok = (int*)(F.ws + WS_ROWTOK); float* roww = (float*)(F.ws + WS_ROWW);
    LAS f32x4* rl = (LAS f32x4*)F.lds;
    __syncthreads();
#pragma unroll
    for (int k = 0; k < 8; ++k) { const int i = F.tid + 512 * k, d = i >> 1, half = i & 1; rl[(((d >> 8) * 4 + (d & 3)) * 2 + half) * 64 + ((d & 255) >> 2)] = ((const GAS f32x4*)rw)[i]; }
    f32x4 gg[8];
#pragma unroll
    for (int j = 0; j < 8; ++j) gg[j] = ((const GAS f32x4*)g + lane)[64 * j];
    __syncthreads();
    f32x4 v[8];
    typedef typename std::conditional<X16, v2u, f32x4>::type XV;
    XV xb[8];
    if (gw < NTOK) {
#pragma unroll
        for (int j = 0; j < 8; ++j) xb[j] = ((const GAS XV*)((const char*)x + (size_t)gw * D * sizeof(XV) / 4) + lane)[64 * j]; }
    for (int t = gw; t < NTOK; t += NGW) {
        { float ssq = 0.f;
#pragma unroll
          for (int j = 0; j < 8; ++j) { if constexpr (X16) { const v2u w = xb[j]; v[j] = (f32x4){bflo(w.x), bfhi(w.x), bflo(w.y), bfhi(w.y)}; } else v[j] = xb[j];
            ssq += (v[j].x * v[j].x + v[j].y * v[j].y) + (v[j].z * v[j].z + v[j].w * v[j].w); }
          if (t + NGW < NTOK) {
#pragma unroll
              for (int j = 0; j < 8; ++j) xb[j] = ((const GAS XV*)((const char*)x + (size_t)(t + NGW) * D * sizeof(XV) / 4) + lane)[64 * j]; }
          const float rstd = 1.0f / sqrtf(wave_sum(ssq) * (1.f / D) + RMS_EPS);
#pragma unroll
          for (int j = 0; j < 8; ++j) v[j] = v[j] * rstd * gg[j]; }
        float lg[8];
#pragma unroll
        for (int e = 0; e < 8; ++e) lg[e] = 0.f;
#pragma unroll
        for (int j = 0; j < 8; ++j)
#pragma unroll
            for (int q = 0; q < 4; ++q) { const f32x4 r0 = rl[((j * 4 + q) * 2) * 64 + lane], r1 = rl[((j * 4 + q) * 2 + 1) * 64 + lane]; const float hv = v[j][q];
                lg[0] = fmaf(hv, r0.x, lg[0]); lg[1] = fmaf(hv, r0.y, lg[1]); lg[2] = fmaf(hv, r0.z, lg[2]); lg[3] = fmaf(hv, r0.w, lg[3]);
                lg[4] = fmaf(hv, r1.x, lg[4]); lg[5] = fmaf(hv, r1.y, lg[5]); lg[6] = fmaf(hv, r1.z, lg[6]); lg[7] = fmaf(hv, r1.w, lg[7]);
                if (q == 3) __builtin_amdgcn_sched_barrier(0); }
#pragma unroll
        for (int e = 0; e < 8; ++e) lg[e] = wave_sum(lg[e]);
        int e1 = 0; float v1 = lg[0];
#pragma unroll
        for (int e = 1; e < 8; ++e) if (lg[e] > v1) { v1 = lg[e]; e1 = e; }
        int e2 = -1; float v2 = -__builtin_inff();
#pragma unroll
        for (int e = 0; e < 8; ++e) if (e != e1 && lg[e] > v2) { v2 = lg[e]; e2 = e; }
        unsigned p1 = 0u, p2 = 0u;
        if (lane == 0) { p1 = __hip_atomic_fetch_add(cnt + e1, 1u, RLX_AGENT); p2 = __hip_atomic_fetch_add(cnt + e2, 1u, RLX_AGENT); }
        unsigned pk[8];
#pragma unroll
        for (int j = 0; j < 8; ++j) pk[j] = pk4_fp8(v[j].x * F8_SA, v[j].y * F8_SA, v[j].z * F8_SA, v[j].w * F8_SA);
        const int row1 = e1 * ECAP + __builtin_amdgcn_readfirstlane((int)p1), row2 = e2 * ECAP + __builtin_amdgcn_readfirstlane((int)p2);
        GAS unsigned* o1 = (GAS unsigned*)(XIN + (size_t)row1 * D) + lane; GAS unsigned* o2 = (GAS unsigned*)(XIN + (size_t)row2 * D) + lane;
#pragma unroll
        for (int j = 0; j < 8; ++j) { o1[64 * j] = pk[j]; o2[64 * j] = pk[j]; }
        if (lane == 0) { const float ex = __expf(v2 - v1);
            rowtok[row1] = 2 * t; roww[row1] = 1.0f / (1.0f + ex); rowtok[row2] = 2 * t + 1; roww[row2] = ex / (1.0f + ex); }
    }
    __syncthreads();
}
struct MoeTiles { int ts[9]; };
__device__ __forceinline__ void moe_counts(const Frame& F, int (&ts)[9]) {
    const GAS v4u* cnt = (const GAS v4u*)((gu32*)(F.ws + WS_CTL) + CW_CNT); int acc = 0;
    const v4u c0 = cnt[0], c1 = cnt[1];
#define MC_STEP(e, val) { ts[e] = acc; const unsigned cn = (unsigned)__builtin_amdgcn_readfirstlane((int)(val)); acc += (int)((cn + 255u) >> 8); }
    MC_STEP(0, c0.x) MC_STEP(1, c0.y) MC_STEP(2, c0.z) MC_STEP(3, c0.w) MC_STEP(4, c1.x) MC_STEP(5, c1.y) MC_STEP(6, c1.z) MC_STEP(7, c1.w)
#undef MC_STEP
    ts[8] = acc;
}
__device__ __forceinline__ void moe_tail_reduce(const Frame& F) {
    int ts[9]; moe_counts(F, ts);
    const int total = ts[8] * 8, first = total & ~255, R = total - first, S = tail_slices(R);
    if (S == 1 || F.G != 256) return;
    MoeOrder M{F.G, 0, 8, ts[8], ts[1], ts[2], ts[3], ts[4], ts[5], ts[6], ts[7], 0};
    const float* PART = (const float*)(F.ws + WS_XIN);
    const int* rowtok = (const int*)(F.ws + WS_ROWTOK); const float* roww = (const float*)(F.ws + WS_ROWW); bf16* Y = (bf16*)(F.ws + WS_XB);
    for (int it = F.vcu * NTHR + F.tid; it < R * 16384; it += F.G * NTHR) {
        const int u = it >> 14, e = it & 16383, r = e >> 6, c4 = (e & 63) * 4;
        pg8::Unit un; M.unit_of(first + u, un);
        const GAS f32x4* p = (const GAS f32x4*)(PART + (size_t)(u * S) * 65536 + (size_t)r * 256 + c4);
        const int row = un.aux * 256 + r, tk = rowtok[row]; const float rw_ = roww[row];
        f32x4 a = p[0];
        { f32x4 q[13];
#pragma unroll
            for (int s = 1; s < 14; ++s) q[s - 1] = (s < S) ? p[(size_t)s * 16384] : (f32x4){0.f, 0.f, 0.f, 0.f};
#pragma unroll
            for (int s = 1; s < 14; ++s) if (s < S) a = a + q[s - 1]; }
        if (tk >= 0) { const float w = rw_ * (1.0f / (F8_SACT * F8_SW)); v2u o; o.x = pk2(a.x * w, a.y * w); o.y = pk2(a.z * w, a.w * w);
            *(GAS v2u*)(Y + (size_t)tk * 2048 + (un.pn & 7) * 256 + c4) = o; }
    }
}
template <bool X16> __device__ __forceinline__ void final_phase(const Frame& F, const float* gfin, float* out) {
    const int gw = F.vcu * NWAVES + F.wave, NGW = F.G * NWAVES, lane = F.lane;
    const float* XA = (const float*)(F.ws + WS_XA); const bf16* Y = (const bf16*)(F.ws + WS_XB);
    for (int t = gw; t < NTOK; t += NGW) {
        const GAS v2u* y0 = (const GAS v2u*)(Y + (size_t)(2 * t) * D) + lane; const GAS v2u* y1 = (const GAS v2u*)(Y + (size_t)(2 * t + 1) * D) + lane;
        f32x4 v[8]; float s = 0.f;
#pragma unroll
        for (int j = 0; j < 8; ++j) { const v2u a = y0[64 * j], bq = y1[64 * j];
            f32x4 xv; if constexpr (X16) { const v2u w = ((const GAS v2u*)((const bf16*)(const void*)XA + (size_t)t * D) + lane)[64 * j]; xv = (f32x4){bflo(w.x), bfhi(w.x), bflo(w.y), bfhi(w.y)}; } else xv = ((const GAS f32x4*)(XA + (size_t)t * D) + lane)[64 * j];
            v[j] = xv + (f32x4){bflo(a.x), bfhi(a.x), bflo(a.y), bfhi(a.y)} + (f32x4){bflo(bq.x), bfhi(bq.x), bflo(bq.y), bfhi(bq.y)};
            s += (v[j].x * v[j].x + v[j].y * v[j].y) + (v[j].z * v[j].z + v[j].w * v[j].w); }
        const float rstd = 1.0f / sqrtf(wave_sum(s) * (1.f / D) + RMS_EPS);
        const GAS f32x4* gr = (const GAS f32x4*)gfin + lane; GAS f32x4* o = (GAS f32x4*)(out + (size_t)t * D) + lane;
#pragma unroll
        for (int j = 0; j < 8; ++j) o[64 * j] = v[j] * rstd * gr[64 * j];
    }
}

constexpr int NPHASE = 23;
__global__ void __launch_bounds__(NTHR, 2) fwd_kernel(Args args) {
    extern __shared__ __attribute__((aligned(16))) unsigned char lds_raw[];
    Frame F;
    F.lds = (LAS unsigned char*)lds_raw; F.ws = args.ws;
    F.tid = threadIdx.x; F.lane = F.tid & 63; F.wave = __builtin_amdgcn_readfirstlane(F.tid >> 6);
    F.G = gridDim.x; { const int bx = blockIdx.x; F.vcu = (F.G % 8 == 0) ? (bx % 8) * (F.G / 8) + bx / 8 : bx; }
    volatile LAS unsigned* MISC = (volatile LAS unsigned*)(F.lds + MISC_OFF);
    for (int u = F.tid; u < (LDS_BYTES - RING_BYTES) / 4; u += NTHR) ((LAS unsigned*)(F.lds + RING_BYTES))[u] = 0u;
    __syncthreads();
    XcdBarrier bar; bar.bar = (unsigned*)(args.ws + WS_CTL) + CW_BAR; bar.x = 0; bar.st = nullptr;
    if (!MK_PER_PHASE) bar = xcd_barrier_post((unsigned*)(args.ws + WS_CTL) + CW_BAR, MISC + 8);
    if (!MK_PER_PHASE && F.tid == 0) __hip_atomic_store((unsigned*)(args.ws + WS_CTL) + CW_XID + blockIdx.x, bar.x + 1u, __ATOMIC_RELAXED, __HIP_MEMORY_SCOPE_AGENT);
    const int lo = args.ph_lo, hi = args.ph_hi;
#ifndef KMASK
#define KMASK 0xFFFFFFFFu
#endif
#define KEN(kind) (((KMASK) >> (kind)) & 1u)
#ifndef DUPMASK
#define DUPMASK 0u
#endif
#define DUP(kind) (((DUPMASK) >> (kind)) & 1u)
#define PHASE(kind, k, ...) do { if (KEN(kind) && IN(k)) { __VA_ARGS__ } if (DUP(kind) && KEN(kind) && IN(k)) { __VA_ARGS__ } } while (0)
#define IN(k) (lo <= (k) && (k) < hi)
#define SEAM(k) do { if (IN(k) && IN((k) + 1)) xcd_barrier(bar); } while (0)
#define BSEAM(k, idx) do { if (IN(k) && IN((k) + 1)) { if (!MK_PER_PHASE && FUSE_RMS && F8_FFN && F.G == 256) batch_barrier((unsigned*)(args.ws + WS_CTL), (int)blockIdx.x, 32u * (unsigned)(idx), MISC + 11); else xcd_barrier(bar); } } while (0)
#define GSEAM(k, idx) do { if (IN(k) && IN((k) + 1)) { if (!MK_PER_PHASE && FUSE_RMS && F8_FFN && F.G == 256) group_barrier((unsigned*)(args.ws + WS_CTL), (int)blockIdx.x, 4u * (unsigned)(idx), MISC + 10); else xcd_barrier(bar); } } while (0)
#define PHASE_BEGIN() const CAS Args* ap = (const CAS Args*)__builtin_amdgcn_kernarg_segment_ptr(); asm volatile("" : "+s"(ap)); Frame Fp = fresh(F); Fp.ws = ap->ws; unsigned char* const ws = Fp.ws; LAS unsigned char* const ring = Fp.lds; const int cB = (int)blockIdx.x; (void)ws; (void)ring; (void)cB

    PHASE(0, 0, PHASE_BEGIN(); prologue(Fp, ap);); SEAM(0);

    for (int L = 0; L < 2; ++L) {
        const int P = 1 + 10 * L;
        PHASE(1, P + 0, PHASE_BEGIN();
            const int hA0 = L == 0 ? NPT : 0, wB0 = L == 0 ? 0 : 64;
            const bf16* base = (const bf16*)(ws + (L == 0 ? WS_W0 : WS_H));
            const int nconv = (L == 0 && Fp.G == 256) ? NCONV : 0, Gg = Fp.G - nconv;
            if (cB < Gg) {
                const bool fused = FUSE_RMS && L == 1 && Fp.G == 256; if (fused) rstd_table(Fp, (const float*)(ws + WS_SLAB) + (size_t)32 * NTOK, fixed_panel(cB));
                pg8::Gemm g{base, base, 0, 0, D}; ProjOrder S{Gg, cB, hA0, wB0}; EpiProj E{ws, hA0, wB0, fused ? (const LAS float*)(Fp.lds + RSTD_OFF) : nullptr};
                pg8::gemm_phase<EpiProj, ProjOrder, true, true>(ring, g, S, E);
            } else convert_items(Fp, ap, (cB - Gg) * NWAVES + Fp.wave, nconv * NWAVES, CBX, CBS1);
        ); if (L == 0) SEAM(P + 0); else BSEAM(P + 0, 1);
        PHASE(2, P + 1, PHASE_BEGIN(); const int nconv = (L == 0 && Fp.G == 256) ? NCONV : 0, Gg = Fp.G - nconv;
            if (cB < Gg) indexer_phase(Fp, nconv > 0, (gu32*)(ws + WS_CTL) + CW_QI, Fp.G == 256 ? cB : Fp.vcu); else convert_items(Fp, ap, (cB - Gg) * NWAVES + Fp.wave, nconv * NWAVES, CBS1, CBS2););
        PHASE(15, P + 1, PHASE_BEGIN(); const int nconv = (L == 0 && Fp.G == 256) ? NCONV : 0, Gg = Fp.G - nconv;
            if (nconv == 0) conv_phase(Fp, ap->in[3] + (size_t)L * 3 * 1024, Fp.vcu, Fp.G); else if (cB < Gg) conv_phase(Fp, ap->in[3] + (size_t)L * 3 * 1024, cB, Gg);); if (L == 0) SEAM(P + 1); else BSEAM(P + 1, 2);
        PHASE(3, P + 2, PHASE_BEGIN(); const int nconv = (L == 0 && Fp.G == 256) ? NCONV : 0, Gg = Fp.G - nconv;
            if (cB < Gg) attn_phase(Fp, nconv > 0, (gu32*)(ws + WS_CTL) + CW_QA, Fp.G == 256 ? cB : Fp.vcu); else convert_items(Fp, ap, (cB - Gg) * NWAVES + Fp.wave, nconv * NWAVES, CBS2, CB10);
            __syncthreads();); if (L == 0) SEAM(P + 2); else BSEAM(P + 2, 3);
        PHASE(4, P + 3, PHASE_BEGIN();
            pg8::Gemm g{(const bf16*)(ws + WS_YMIX), (const bf16*)(ws + WS_WC) + (size_t)L * D * D, 0, 0, D}; PlainOrder S{64, 8, Fp.G, cB, 0, 0}; EpiMix E{ws};
            pg8::gemm_phase<EpiMix, PlainOrder, true, true>(ring, g, S, E);
        ); GSEAM(P + 3, L == 0 ? 1 : 5);
        PHASE(6, P + 5, PHASE_BEGIN();
            const bool fz = FUSE_RMS && F8_FFN && Fp.G == 256;
            pg8::Gemm g{(const bf16*)(ws + WS_Z), (const bf16*)(ws + WS_WO) + (size_t)L * D * D, 0, 0, D}; PlainOrder S{64, 8, Fp.G, cB, 0, 0};
            if (fz && L == 0) { EpiRes2<true, true, true> E{(const void*)(ws + WS_H), (void*)(ws + WS_XA), 1.0f, ap->in[7], (void*)(ws + WS_XB), (float*)(ws + WS_SLAB), ap->in[1], (const float*)(ws + WS_RMS0)};
                pg8::gemm_phase<EpiRes2<true, true, true>, PlainOrder, true, true>(ring, g, S, E); }
            else if (fz) { EpiRes<true, true> E{(const void*)(ws + WS_H), (void*)(ws + WS_XA), 1.0f, ap->in[1] + D};
                pg8::gemm_phase<EpiRes<true, true>, PlainOrder, true, true>(ring, g, S, E); }
            else { EpiRes<false, false> E{L == 0 ? (const void*)ap->in[0] : (const void*)(ws + WS_XB), (void*)(ws + WS_XA), 1.0f, nullptr};
                pg8::gemm_phase<EpiRes<false, false>, PlainOrder, true, true>(ring, g, S, E); }
        ); if (L == 0) GSEAM(P + 5, 2); else SEAM(P + 5);
        PHASE(7, P + 6, PHASE_BEGIN();
            if (L == 0 && FUSE_RMS && F8_FFN && Fp.G == 256) {   }
            else if (L == 0) { if (F8_FFN) rms_pass_f8(Fp, (const float*)(ws + WS_XA), ap->in[7], (unsigned char*)(ws + WS_H)); else rms_pass(Fp, (const float*)(ws + WS_XA), ap->in[7], (bf16*)(ws + WS_H)); }
            else if (FUSE_RMS && F8_FFN && Fp.G == 256) router_phase<true>(Fp, (const void*)(ws + WS_XA), ap->in[7] + D, ap->in[11]); else router_phase<false>(Fp, (const void*)(ws + WS_XA), ap->in[7] + D, ap->in[11]);
        ); if (!(L == 0 && FUSE_RMS && F8_FFN && F.G == 256)) SEAM(P + 6);
        if (L == 0) {
            PHASE(8, P + 7, PHASE_BEGIN();
                if constexpr (F8_FFN) { const bool fused = FUSE_RMS && Fp.G == 256; pg8::Gemm g{(const bf16*)(ws + (fused ? WS_XB : WS_H)), (const bf16*)(ws + WS_W13), 0, 0, D / 2}; PlainOrder S{64, 44, Fp.G, cB, 0, 0}; if (fused) rstd_table(Fp, (const float*)(ws + WS_SLAB), fixed_panel(cB));
                    EpiSwigluF8 E{(unsigned char*)(ws + WS_ACT), FF, 44, fused ? (const LAS float*)(Fp.lds + RSTD_OFF) : nullptr, 0};
                    pg8::gemm_phase<EpiSwigluF8, PlainOrder, true, true, true>(ring, g, S, E); }
                else { pg8::Gemm g{(const bf16*)(ws + WS_H), (const bf16*)(ws + WS_W13), 0, 0, D}; PlainOrder S{64, 44, Fp.G, cB, 0, 0}; EpiSwiglu E{(bf16*)(ws + WS_ACT), FF, 44};
                    pg8::gemm_phase<EpiSwiglu, PlainOrder, true, true>(ring, g, S, E); }
            ); GSEAM(P + 7, 3);
            PHASE(9, P + 8, PHASE_BEGIN();
                if constexpr (F8_FFN) { pg8::Gemm g{(const bf16*)(ws + WS_ACT), (const bf16*)(ws + WS_W2), 0, 0, FF / 2}; PlainOrder S{64, 8, Fp.G, cB, 0, 0}; if (FUSE_RMS && Fp.G == 256) { EpiRes2<false, true, true> E{(const void*)(ws + WS_XA), nullptr, 1.0f / (F8_SACT * F8_SW), ap->in[1] + D, (void*)(ws + WS_H), (float*)(ws + WS_SLAB) + (size_t)32 * NTOK, nullptr, nullptr};
                        pg8::gemm_phase<EpiRes2<false, true, true>, PlainOrder, true, true, true>(ring, g, S, E); }
                    else { EpiRes<false, false> E{(const void*)(ws + WS_XA), (void*)(ws + WS_XB), 1.0f / (F8_SACT * F8_SW), nullptr};
                        pg8::gemm_phase<EpiRes<false, false>, PlainOrder, true, true, true>(ring, g, S, E); } }
                else { pg8::Gemm g{(const bf16*)(ws + WS_ACT), (const bf16*)(ws + WS_W2), 0, 0, FF}; PlainOrder S{64, 8, Fp.G, cB, 0, 0}; EpiRes<false, false> E{(const void*)(ws + WS_XA), (void*)(ws + WS_XB), 1.0f, nullptr};
                    pg8::gemm_phase<EpiRes<false, false>, PlainOrder, true, true>(ring, g, S, E); }
            ); GSEAM(P + 8, 4);
            PHASE(10, P + 9, PHASE_BEGIN(); if (!(FUSE_RMS && F8_FFN && Fp.G == 256)) rms_pass(Fp, (const float*)(ws + WS_XB), ap->in[1] + D, (bf16*)(ws + WS_H));); if (!(FUSE_RMS && F8_FFN && F.G == 256)) SEAM(P + 9);
        } else {
            PHASE(12, P + 8, PHASE_BEGIN();
                int ts[9]; moe_counts(Fp, ts);
                pg8::Gemm g{(const bf16*)(ws + WS_XIN), (const bf16*)(ws + WS_EW13), 0, 0, D / 2};
                MoeOrder S{Fp.G, cB, 56, ts[8], ts[1], ts[2], ts[3], ts[4], ts[5], ts[6], ts[7], 1}; EpiSwigluF8 E{(unsigned char*)(ws + WS_EACT), FFE, 56, nullptr, 1};
                pg8::gemm_phase<EpiSwigluF8, MoeOrder, true, true, true>(ring, g, S, E);
            ); SEAM(P + 8);
            PHASE(13, P + 9, PHASE_BEGIN();
                int ts[9]; moe_counts(Fp, ts);
                const int total = ts[8] * 8, first = total & ~255, R = total - first, S = (Fp.G == 256) ? tail_slices(R) : 1;
                MoeOrder S0{Fp.G, cB, 8, ts[8], ts[1], ts[2], ts[3], ts[4], ts[5], ts[6], ts[7], 0}; if (S > 1) S0.limit = first;
                { pg8::Gemm g{(const bf16*)(ws + WS_EACT), (const bf16*)(ws + WS_EW2), 0, 0, FFE / 2}; EpiMoeDown E{ws};
                  pg8::gemm_phase<EpiMoeDown, MoeOrder, true, true, true>(ring, g, S0, E); }
                if (S > 1) { pg8::Gemm g{(const bf16*)(ws + WS_EACT), (const bf16*)(ws + WS_EW2), 0, 0, FFE / 2, (FFE / 2) / S}; MoeTailOrder S1{S0, first, R, S}; EpiPartial E{(float*)(ws + WS_XIN) + (size_t)cB * 65536};
                  pg8::gemm_phase<EpiPartial, MoeTailOrder, true, true, true>(ring, g, S1, E); }
            ); SEAM(P + 9);
        }
    }
    PHASE(16, 21, PHASE_BEGIN(); moe_tail_reduce(Fp);); SEAM(21);
    PHASE(14, 22, PHASE_BEGIN(); if (FUSE_RMS && F8_FFN && Fp.G == 256) final_phase<true>(Fp, ap->in[15], ap->out); else final_phase<false>(Fp, ap->in[15], ap->out););
#undef IN
#undef SEAM
}

extern "C" void kernel_launch(void* const* d_in, const int* in_sizes, int n_in, void* d_out, int out_size, void* d_ws, size_t ws_size, hipStream_t stream) {
    static int grid = 0;
    if (grid == 0) {
        if (n_in != 16 || out_size != NTOK * D || ws_size < WS_END) { fprintf(stderr, "kernel_launch: unexpected shapes (n_in %d, out %d, ws %zu < %zu)\n", n_in, out_size, ws_size, (size_t)WS_END); grid = -1; return; }
        int dev = 0, cus = 0, per_cu = 0;
        if (hipGetDevice(&dev) != hipSuccess || hipDeviceGetAttribute(&cus, hipDeviceAttributeMultiprocessorCount, dev) != hipSuccess) { grid = -1; return; }
        if (hipFuncSetAttribute((const void*)fwd_kernel, hipFuncAttributeMaxDynamicSharedMemorySize, LDS_BYTES) != hipSuccess) { fprintf(stderr, "kernel_launch: hipFuncSetAttribute failed\n"); grid = -1; return; }
        if (hipOccupancyMaxActiveBlocksPerMultiprocessor(&per_cu, (const void*)fwd_kernel, NTHR, LDS_BYTES) != hipSuccess || per_cu < 1) fprintf(stderr, "kernel_launch: occupancy query says %d\n", per_cu);
        (void)hipGetLastError();
        grid = cus;
    }
    if (grid < 0) return;
    (void)hipMemsetAsync((char*)d_ws + WS_CTL, 0, CTL_ZERO_BYTES, stream);
    Args a{};
    for (int i = 0; i < 16; ++i) a.in[i] = (const float*)d_in[i];
    a.out = (float*)d_out; a.ws = (unsigned char*)d_ws;
#if MK_PER_PHASE
    for (int p = 0; p < NPHASE; ++p) { a.ph_lo = p; a.ph_hi = p + 1; hipLaunchKernelGGL(fwd_kernel, dim3(grid), dim3(NTHR), LDS_BYTES, stream, a); }
#else
    a.ph_lo = 0; a.ph_hi = NPHASE;
    hipLaunchKernelGGL(fwd_kernel, dim3(grid), dim3(NTHR), LDS_BYTES, stream, a);
#endif
}
```

```cpp
#include <hip/hip_runtime.h>
#include <cstdio>
#include <cstdint>
#include <type_traits>
#ifndef MK_PER_PHASE
#define MK_PER_PHASE 0
#endif
#define DUPMASK_CFG 0u
#define DUPMASK DUPMASK_CFG
namespace pg8 {
#define PG8_LAS __attribute__((address_space(3)))
typedef unsigned short bf16_t;
typedef short bf16x8 __attribute__((ext_vector_type(8)));
typedef float f32x4 __attribute__((ext_vector_type(4)));
typedef unsigned u32x4 __attribute__((ext_vector_type(4)));
constexpr int BM = 256, BK = 64, HALF = 128, HTB = HALF * BK * 2  , STAGE_BYTES = 8 * HTB, NXCD = 8, WGM = 8;

__host__ __device__ __forceinline__ int lds_byte(int r, int c) { const int st = (r >> 4) * 2 + (c >> 5), rr = r & 15, cc = c & 31, ob = rr * 64 + cc * 2; return st * 1024 + (ob ^ (((ob >> 9) & 1) << 5)); }
__host__ __device__ __forceinline__ void stage_rc(int b, int& R, int& C) { const int st = b / 1024, sb = b % 1024, swz = sb ^ (((sb >> 9) & 1) << 5); R = (st >> 1) * 16 + swz / 64; C = (st & 1) * 32 + (swz % 64) / 2; }
__host__ __device__ __forceinline__ int perm32(int rho) { const int n = rho >> 4, i = rho & 15; return 8 * (i >> 2) + 4 * n + (i & 3); }

struct Unit { int pm, pn; int aux = 0; int ks = 0; };
struct Gemm { const bf16_t* A; const bf16_t* Bt; int M, N, K; int Kloop = 0; };

struct StaticOrder {
    int nM, nN, nwg, G, c;
    __host__ __device__ void init(int M, int N, int G_, int c_) { nM = M / BM; nN = N / BM; nwg = nM * nN; G = G_; c = c_; }
    __host__ __device__ bool next(int i, Unit& u) const {
        const long L = (long)i * G + c; if (L >= nwg) return false;
        int wgid = (int)L; { const int q = nwg / NXCD, r = nwg % NXCD, xcd = wgid % NXCD, off = wgid / NXCD; wgid = (xcd < r ? xcd * (q + 1) : r * (q + 1) + (xcd - r) * q) + off; }
        const int nig = WGM * nN, gid = wgid / nig, fm = gid * WGM, gsz = (nM - fm) < WGM ? (nM - fm) : WGM;
        u.pm = fm + ((wgid % nig) % gsz); u.pn = (wgid % nig) / gsz; return true;
    }
    __device__ __forceinline__ void a_ready(const Unit&) const {}
    __device__ __forceinline__ void done(const Unit&) const {}
};
__device__ __forceinline__ unsigned cvt_pk_bf16(float lo, float hi) { unsigned r; asm volatile("v_cvt_pk_bf16_f32 %0, %1, %2" : "=v"(r) : "v"(lo), "v"(hi)); return r; }
typedef int i32x4_t __attribute__((ext_vector_type(4))); typedef int i32x8_t __attribute__((ext_vector_type(8)));
template <class Epi, class Sched, bool ALIGN_EPI = false, bool SP2 = false, bool FP8 = false>
__device__ __forceinline__ void gemm_phase(PG8_LAS unsigned char* lds, const Gemm g, const Sched& S, const Epi& E) {
    int tid_ = threadIdx.x; asm volatile("" : "+v"(tid_));
    const int tid = tid_, wid = __builtin_amdgcn_readfirstlane(tid >> 6), lane = tid & 63, wr = wid >> 2, wc = wid & 3, fr = lane & 15, fq = lane >> 4;
    const int K = g.K, Kl = g.Kloop ? g.Kloop : g.K, nt = Kl / BK; const size_t ksl = (size_t)Kl * 2;
    unsigned voffA[2], voffB[2];
#pragma unroll
    for (int i = 0; i < 2; ++i) { int R, C; stage_rc(tid * 16 + i * 8192, R, C); const int Rb = Epi::PERM ? ((R & ~31) + perm32(R & 31)) : R;
        voffA[i] = (unsigned)(R * K + C) * 2u; voffB[i] = (unsigned)(Rb * K + C) * 2u; }
    const size_t kstep = (size_t)(BK * 2);
    const size_t hstep = (size_t)HALF * K * 2;
    const size_t tstep = 2 * hstep;
    const unsigned ldsw = (unsigned)wid * 1024u; const unsigned ldsbase = (unsigned)__builtin_amdgcn_readfirstlane((int)((unsigned)(size_t)lds + ldsw));
    int aoff = lds_byte(wr * 64 + fr, fq * 8), boff = lds_byte(wc * 32 + fr, fq * 8);
    int boffB = boff + 4 * HTB;
    asm volatile("" : "+v"(aoff), "+v"(boffB));
#define PG8_SA(b, h) (((b) * 2 + (h)) * HTB)
#define PG8_SB(b, h) ((4 + (b) * 2 + (h)) * HTB)
#define PG8_GLDS(sbase, vo, ldsaddr) asm volatile("s_mov_b32 m0, %2\n\ts_nop 0\n\tglobal_load_lds_dwordx4 %0, %1" :: "v"(vo), "s"(sbase), "s"(ldsaddr) : "memory")
#define PG8_STAGE(bufoff, gbase, voff) do { _Pragma("unroll") for (int _i = 0; _i < 2; ++_i) PG8_GLDS((const char*)(gbase), (voff)[_i], ldsbase + (unsigned)((bufoff) + _i * 8192)); } while (0)
#define PG8_RD16(off) (*(const PG8_LAS i32x4_t*)(lds + (off)))
#define PG8_LDA(dst, b, h) do { _Pragma("unroll") for (int m = 0; m < 4; ++m) { if constexpr (FP8) { dst##8[m] = __builtin_shufflevector(PG8_RD16(PG8_SA(b, h) + aoff + m * 2048), PG8_RD16(PG8_SA(b, h) + aoff + m * 2048 + 1024), 0, 1, 2, 3, 4, 5, 6, 7); } \
        else { _Pragma("unroll") for (int k = 0; k < 2; ++k) dst[m][k] = *(const PG8_LAS bf16x8*)(lds + PG8_SA(b, h) + aoff + m * 2048 + k * 1024); } } } while (0)
#define PG8_LDB(dst, b, h) do { _Pragma("unroll") for (int n = 0; n < 2; ++n) { if constexpr (FP8) { dst##8[n] = __builtin_shufflevector(PG8_RD16(PG8_SA(b, h) + boffB + n * 2048), PG8_RD16(PG8_SA(b, h) + boffB + n * 2048 + 1024), 0, 1, 2, 3, 4, 5, 6, 7); } \
        else { _Pragma("unroll") for (int k = 0; k < 2; ++k) dst[n][k] = *(const PG8_LAS bf16x8*)(lds + PG8_SA(b, h) + boffB + n * 2048 + k * 1024); } } } while (0)
#define PG8_MMA(ai, bj, At, Bt) do { __builtin_amdgcn_s_setprio(1); _Pragma("unroll") for (int m = 0; m < 4; ++m) _Pragma("unroll") for (int n = 0; n < 2; ++n) { \
        if constexpr (FP8) { asm("s_nop 1\n\tv_mfma_scale_f32_16x16x128_f8f6f4 %0, %1, %2, %0, %3, %3 op_sel_hi:[0,0,0]" : "+v"(acc[ai][bj][m][n]) : "v"(Bt##8[n]), "v"(At##8[m]), "v"(f8scale)); } \
        else { _Pragma("unroll") for (int k = 0; k < 2; ++k) acc[ai][bj][m][n] = __builtin_amdgcn_mfma_f32_16x16x32_bf16(Bt[n][k], At[m][k], acc[ai][bj][m][n], 0, 0, 0); } } \
        __builtin_amdgcn_s_setprio(0); } while (0)
#define PG8_WAIT_V(n) asm volatile("s_waitcnt vmcnt(" #n ")" ::: "memory")
#define PG8_WAIT_V8() do { if constexpr (Epi::NST > 0) { if (t == 0 && ui > 0) asm volatile("s_waitcnt vmcnt(%0)" :: "n"(8 + Epi::NST) : "memory"); else PG8_WAIT_V(8); } else PG8_WAIT_V(8); } while (0)
#define PG8_WAIT_L(n) asm volatile("s_waitcnt lgkmcnt(" #n ")" ::: "memory")
#define PG8_BAR __builtin_amdgcn_s_barrier()
#define PG8_SCHED __builtin_amdgcn_sched_barrier(0)
    Unit cur, nxt; int ui = 0;
    if (!S.next(0, cur)) return;
    f32x4 acc[2][2][4][2];
#pragma unroll
    for (int a = 0; a < 2; ++a)
#pragma unroll
        for (int b = 0; b < 2; ++b)
#pragma unroll
            for (int m = 0; m < 4; ++m)
#pragma unroll
                for (int n = 0; n < 2; ++n) acc[a][b][m][n] = (f32x4){0.f, 0.f, 0.f, 0.f};
    bf16x8 At[4][2], B0[2][2], B1[2][2]; i32x8_t At8[4], B08[2], B18[2]; int f8scale = 0x7F7F7F7F; asm volatile("" : "+v"(f8scale));
    const char* cA = (const char*)g.A + (size_t)__builtin_amdgcn_readfirstlane(cur.pm) * tstep + (size_t)__builtin_amdgcn_readfirstlane(cur.ks) * ksl; const char* cB = (const char*)g.Bt + (size_t)__builtin_amdgcn_readfirstlane(cur.pn) * tstep + (size_t)__builtin_amdgcn_readfirstlane(cur.ks) * ksl;
    S.a_ready(cur);
    if constexpr (SP2) {
        PG8_STAGE(PG8_SB(0, 0), cB, voffB); PG8_STAGE(PG8_SB(0, 1), cB + hstep, voffB); PG8_STAGE(PG8_SA(0, 0), cA, voffA); PG8_STAGE(PG8_SA(0, 1), cA + hstep, voffA);
        if (wr == 1) PG8_BAR;
        PG8_WAIT_V(2); PG8_BAR;
        PG8_STAGE(PG8_SB(1, 0), cB + kstep, voffB); PG8_STAGE(PG8_SA(1, 0), cA + kstep, voffA); PG8_STAGE(PG8_SB(1, 1), cB + hstep + kstep, voffB);
        PG8_WAIT_V(6); PG8_BAR;
    } else {
        PG8_STAGE(PG8_SB(0, 0), cB, voffB); PG8_STAGE(PG8_SA(0, 0), cA, voffA); PG8_STAGE(PG8_SB(0, 1), cB + hstep, voffB); PG8_STAGE(PG8_SA(0, 1), cA + hstep, voffA);
        if (wr == 1) PG8_BAR;
        PG8_WAIT_V(4); PG8_BAR;
        PG8_STAGE(PG8_SB(1, 0), cB + kstep, voffB); PG8_STAGE(PG8_SA(1, 0), cA + kstep, voffA); PG8_STAGE(PG8_SB(1, 1), cB + hstep + kstep, voffB);
        PG8_WAIT_V(6); PG8_BAR;
    }
    for (;;) {
        const bool has_next = S.next(ui + 1, nxt);
        const char* nA = has_next ? (const char*)g.A + (size_t)__builtin_amdgcn_readfirstlane(nxt.pm) * tstep + (size_t)__builtin_amdgcn_readfirstlane(nxt.ks) * ksl : cA; const char* nB = has_next ? (const char*)g.Bt + (size_t)__builtin_amdgcn_readfirstlane(nxt.pn) * tstep + (size_t)__builtin_amdgcn_readfirstlane(nxt.ks) * ksl : cB;
        for (int t = 0; t < nt; t += 2) {
            const bool last = (t == nt - 2);
            const char* a1 = cA + (size_t)(t + 1) * kstep;
            const char* a2 = last ? nA : cA + (size_t)(t + 2) * kstep; const char* b2 = last ? nB : cB + (size_t)(t + 2) * kstep;
            const char* a3 = a2 + kstep; const char* b3 = b2 + kstep;
            if (last && has_next) S.a_ready(nxt);
            if constexpr (Epi::HAS_MID) { if (t == nt / 2) { int fr_ = fr, fq_ = fq; asm volatile("" : "+v"(fr_), "+v"(fq_)); E.mid(acc, cur, wr, wc, fr_, fq_); } }
            if constexpr (SP2) {
            PG8_LDB(B0, 0, 0); PG8_LDB(B1, 0, 1); PG8_SCHED; PG8_LDA(At, 0, 0); PG8_STAGE(PG8_SA(1, 1), a1 + hstep, voffA);
            if (t == 0 && ui > 0) {
#pragma unroll
                for (int a = 0; a < 2; ++a)
#pragma unroll
                    for (int b = 0; b < 2; ++b)
#pragma unroll
                        for (int m = 0; m < 4; ++m)
#pragma unroll
                            for (int n = 0; n < 2; ++n) acc[a][b][m][n] = (f32x4){0.f, 0.f, 0.f, 0.f};
            }
            PG8_WAIT_V8(); PG8_WAIT_L(0); PG8_BAR; PG8_MMA(0, 0, At, B0); PG8_MMA(0, 1, At, B1); PG8_BAR; PG8_SCHED;
            PG8_LDA(At, 0, 1); PG8_STAGE(PG8_SB(0, 0), b2, voffB); PG8_STAGE(PG8_SB(0, 1), b2 + hstep, voffB); PG8_STAGE(PG8_SA(0, 0), a2, voffA);
            PG8_WAIT_V8(); PG8_WAIT_L(0); PG8_BAR; PG8_MMA(1, 0, At, B0); PG8_MMA(1, 1, At, B1); PG8_BAR; PG8_SCHED;
            PG8_LDB(B0, 1, 0); PG8_LDB(B1, 1, 1); PG8_SCHED; PG8_LDA(At, 1, 0); PG8_STAGE(PG8_SA(0, 1), a2 + hstep, voffA);
            PG8_WAIT_V8(); PG8_WAIT_L(0); PG8_BAR; PG8_MMA(0, 0, At, B0); PG8_MMA(0, 1, At, B1); PG8_BAR; PG8_SCHED;
            PG8_LDA(At, 1, 1); PG8_STAGE(PG8_SB(1, 0), b3, voffB); PG8_STAGE(PG8_SB(1, 1), b3 + hstep, voffB); PG8_STAGE(PG8_SA(1, 0), a3, voffA);
            PG8_WAIT_V8(); PG8_WAIT_L(0); PG8_BAR; PG8_MMA(1, 0, At, B0); PG8_MMA(1, 1, At, B1); PG8_BAR; PG8_SCHED;
            } else {
            PG8_LDB(B0, 0, 0); PG8_SCHED; PG8_LDA(At, 0, 0); PG8_STAGE(PG8_SA(1, 1), a1 + hstep, voffA);
            if (t == 0 && ui > 0) {
#pragma unroll
                for (int a = 0; a < 2; ++a)
#pragma unroll
                    for (int b = 0; b < 2; ++b)
#pragma unroll
                        for (int m = 0; m < 4; ++m)
#pragma unroll
                            for (int n = 0; n < 2; ++n) acc[a][b][m][n] = (f32x4){0.f, 0.f, 0.f, 0.f};
            }
            PG8_WAIT_L(8); PG8_BAR; PG8_WAIT_L(0); PG8_MMA(0, 0, At, B0); PG8_BAR; PG8_SCHED;
            PG8_LDB(B1, 0, 1); PG8_STAGE(PG8_SB(0, 0), b2, voffB);
            PG8_BAR; PG8_WAIT_L(0); PG8_MMA(0, 1, At, B1); PG8_BAR;
            PG8_LDA(At, 0, 1); PG8_STAGE(PG8_SA(0, 0), a2, voffA);
            PG8_BAR; PG8_WAIT_L(0); PG8_MMA(1, 0, At, B0); PG8_BAR; PG8_SCHED;
            PG8_STAGE(PG8_SB(0, 1), b2 + hstep, voffB);
            PG8_WAIT_V(6); PG8_BAR; PG8_MMA(1, 1, At, B1); PG8_BAR;
            PG8_LDB(B0, 1, 0); PG8_SCHED; PG8_LDA(At, 1, 0); PG8_STAGE(PG8_SA(0, 1), a2 + hstep, voffA);
            PG8_WAIT_L(8); PG8_BAR; PG8_WAIT_L(0); PG8_MMA(0, 0, At, B0); PG8_BAR; PG8_SCHED;
            PG8_LDB(B1, 1, 1); PG8_STAGE(PG8_SB(1, 0), b3, voffB);
            PG8_BAR; PG8_WAIT_L(0); PG8_MMA(0, 1, At, B1); PG8_BAR;
            PG8_LDA(At, 1, 1); PG8_STAGE(PG8_SA(1, 0), a3, voffA);
            PG8_BAR; PG8_WAIT_L(0); PG8_MMA(1, 0, At, B0); PG8_BAR; PG8_SCHED;
            PG8_STAGE(PG8_SB(1, 1), b3 + hstep, voffB);
            PG8_WAIT_V(6); PG8_BAR; PG8_MMA(1, 1, At, B1); PG8_BAR;
            }
        }
        if constexpr (ALIGN_EPI) { if (wr == 0) PG8_BAR; }
        if constexpr (FP8) asm volatile("s_nop 15\n\ts_nop 15" ::: "memory");
        if constexpr (!Epi::AFTER_DRAIN) { int fr_ = fr, fq_ = fq; asm volatile("" : "+v"(fr_), "+v"(fq_));
            E(acc, cur, wr, wc, fr_, fq_);
#if defined(PROBE_EPIDUP)
            if constexpr (!Epi::NOT_IDEMPOTENT) { asm volatile("" : "+v"(fr_), "+v"(fq_)); E(acc, cur, wr, wc, fr_, fq_); }
#endif
            S.done(cur); }
        if (!has_next) break;
        cur = nxt; cA = nA; cB = nB; ++ui;
        if constexpr (ALIGN_EPI) { if (wr == 1) PG8_BAR; }
    }
    PG8_WAIT_V(0);
    if constexpr (!ALIGN_EPI) { if (wr == 0) PG8_BAR; }
    PG8_BAR;
    if constexpr (Epi::AFTER_DRAIN) { E.fused(acc, cur, wr, wc, fr, fq, lds, wid, lane); S.done(cur); }
#undef PG8_SA
#undef PG8_SB
#undef PG8_STAGE
#undef PG8_GLDS
#undef PG8_LDA
#undef PG8_LDB
#undef PG8_MMA
#undef PG8_RD16
#undef PG8_WAIT_V
#undef PG8_WAIT_V8
#undef PG8_WAIT_L
#undef PG8_BAR
#undef PG8_SCHED
}
}

constexpr int NB = 8, T = 2048, D = 2048, NTOK = NB * T;
constexpr int INC = 9808, INP = 9984, NPT = INP / 256;
constexpr int FF = 5632, NE = 8, FFE = 7168, TOPK = 256;
constexpr int MAXROWS = 34816;
constexpr float RMS_EPS = 1e-6f;
constexpr int NWAVES = 8, NTHR = 512;

constexpr size_t MiB = 1u << 20;
constexpr size_t WS_CTL = 0, CTL_ZERO_BYTES = 1 * MiB;
constexpr size_t WS_W0 = 1 * MiB;
constexpr size_t WS_H = 40 * MiB;
constexpr size_t WS_W1 = 104 * MiB;
constexpr size_t WS_WC = 143 * MiB;
constexpr size_t WS_WA = 151 * MiB;
constexpr size_t WS_WO = 159 * MiB;
constexpr size_t WS_W13 = 175 * MiB;
constexpr size_t WS_W2 = 219 * MiB;
constexpr size_t WS_EW13 = 241 * MiB;
constexpr size_t WS_EW2 = 689 * MiB;
constexpr size_t WS_XA = 913 * MiB;
constexpr size_t WS_XB = 1041 * MiB;
constexpr size_t WS_S = 1169 * MiB;
constexpr size_t WS_BCU = WS_S;
constexpr size_t WS_Q = WS_S + 96 * MiB;
constexpr size_t WS_K = WS_S + 128 * MiB;
constexpr size_t WS_VT = WS_S + 136 * MiB;
constexpr size_t WS_QI = WS_S + 144 * MiB;
constexpr size_t WS_KW = WS_S + 176 * MiB;
constexpr size_t WS_GT = WS_S + 184 * MiB;
constexpr size_t WS_MASK = WS_S + 312 * MiB;
constexpr size_t WS_YMIX = WS_S + 316 * MiB;
constexpr size_t WS_ATT = WS_S + 348 * MiB;
constexpr size_t WS_Z = WS_S + 380 * MiB;
constexpr size_t WS_ACT = WS_XB + 32 * MiB;
constexpr int ECAP = 16384, ECAPT = ECAP / 256;
constexpr size_t WS_XIN = WS_S;
constexpr size_t WS_EACT = WS_S + 256 * MiB;
constexpr size_t WS_MISC = 1781 * MiB;
constexpr size_t WS_ROWTOK = WS_MISC, WS_ROWW = WS_MISC + 512 * 1024;
constexpr size_t WS_SLAB = 1783 * MiB;
constexpr size_t WS_RMS0 = 1787 * MiB;
constexpr size_t WS_END = 1788 * MiB;
constexpr int CW_CNT = 64;
constexpr int CW_QI = 128, CW_QA = 192;
constexpr int CW_BAR = 4096;
constexpr int CW_GB = 8192;
constexpr int CW_BB = 12288;
constexpr int CW_XID = 16384;

constexpr int RING_BYTES = 131072;
constexpr int MISC_OFF = RING_BYTES + 320;
constexpr int QSLOT_OFF = RING_BYTES + 8192;
constexpr int RSTD_OFF = RING_BYTES + 4096;
constexpr int LDS_BYTES = 147456;

#define GAS __attribute__((address_space(1)))
#define LAS __attribute__((address_space(3)))
typedef unsigned short bf16;
typedef unsigned v4u __attribute__((ext_vector_type(4)));
typedef unsigned v2u __attribute__((ext_vector_type(2)));
typedef float f32x4 __attribute__((ext_vector_type(4)));
typedef float f32x16 __attribute__((ext_vector_type(16)));
typedef float f32x2 __attribute__((ext_vector_type(2)));
typedef short bf16x8 __attribute__((ext_vector_type(8)));
typedef GAS unsigned gu32;
#define RLX_AGENT __ATOMIC_RELAXED, __HIP_MEMORY_SCOPE_AGENT
#define LDS_WAIT() asm volatile("s_waitcnt lgkmcnt(0)" ::: "memory")
#define VM_WAIT() asm volatile("s_waitcnt vmcnt(0)" ::: "memory")
__device__ __forceinline__ unsigned pk2(float lo, float hi) { return pg8::cvt_pk_bf16(lo, hi); }
__device__ __forceinline__ float bflo(unsigned w) { return __builtin_bit_cast(float, w << 16); }
__device__ __forceinline__ float bfhi(unsigned w) { return __builtin_bit_cast(float, w & 0xffff0000u); }
__device__ __forceinline__ float fast_exp2(float x) { return __builtin_amdgcn_exp2f(x); }
__device__ __forceinline__ float sigmoidf_(float x) { return __builtin_amdgcn_rcpf(1.0f + fast_exp2(-1.4426950408889634f * x)); }
__device__ __forceinline__ float siluf_(float x) { return x * sigmoidf_(x); }
__device__ __forceinline__ unsigned pk4_fp8(float a, float b, float c, float d) {
    a = __builtin_amdgcn_fmed3f(a, -448.f, 448.f); b = __builtin_amdgcn_fmed3f(b, -448.f, 448.f); c = __builtin_amdgcn_fmed3f(c, -448.f, 448.f); d = __builtin_amdgcn_fmed3f(d, -448.f, 448.f);
    int w = 0; w = __builtin_amdgcn_cvt_pk_fp8_f32(a, b, w, false); w = __builtin_amdgcn_cvt_pk_fp8_f32(c, d, w, true); return (unsigned)w; }
constexpr int NCONV = 64;
constexpr int CONV_PROLOGUE_PCT = 0;
constexpr int CONV_S1_PCT = 0, CONV_S2_PCT = 0;
constexpr bool FUSE_RMS = true;
constexpr bool F8_FFN = true;
constexpr float F8_SW = 256.f, F8_SA = 8.f, F8_SACT = 8.f;
__device__ __forceinline__ float wave_sum(float v) {
#pragma unroll
    for (int o = 1; o < 64; o <<= 1) v += __shfl_xor(v, o);
    return v;
}
#define XB_TMO      128
#define XB_XCNT(j)  (256  + 64 * (j))
#define XB_XSUB(j)  (1280 + 64 * (j))
#define XB_XGEN(j)  (2304 + 64 * (j))
#define XB_TOP      3328
#define XB_TOPGEN   3392
#define XCD_BAR_WORDS 3456
#define XB_SPIN_CAP (1u << 18)

__device__ __forceinline__ unsigned xb_ld(unsigned* p)              { return __hip_atomic_load(p, __ATOMIC_RELAXED, __HIP_MEMORY_SCOPE_AGENT); }
__device__ __forceinline__ unsigned xb_add(unsigned* p, unsigned v) { return __hip_atomic_fetch_add(p, v, __ATOMIC_RELAXED, __HIP_MEMORY_SCOPE_AGENT); }
__device__ __forceinline__ unsigned xb_xcc_id() { return (unsigned)__builtin_amdgcn_s_getreg((3 << 11) | 20) & 0xFu; }
#define XB_SPIN(cond, bar) do { unsigned _sp = 0; while (cond) { __builtin_amdgcn_s_sleep(1); \
    if ((++_sp & 255u) == 0u) { if (xb_ld(&(bar)[XB_TMO])) break; if (_sp > XB_SPIN_CAP) { atomicAdd(&(bar)[XB_TMO], 1u); break; } } } } while (0)

struct XcdBarrier {
    unsigned* bar; unsigned x;
    volatile LAS unsigned* st;
};

__device__ __forceinline__ XcdBarrier xcd_barrier_post(unsigned* bar, volatile LAS unsigned* st) {
    XcdBarrier b; b.bar = bar; b.x = xb_xcc_id(); b.st = st;
    if (threadIdx.x == 0) (void)xb_add(&bar[XB_XCNT(b.x)], 1u);
    return b;
}
__device__ __forceinline__ void xcd_barrier_complete(unsigned* bar, unsigned x, unsigned& nloc, unsigned& nx) {
    const unsigned G = gridDim.x * gridDim.y * gridDim.z;
    unsigned sum, cnt, mine, sp = 0u;
    for (;;) {
        sum = 0u; cnt = 0u; mine = 0u;
#pragma unroll
        for (unsigned j = 0; j < 16; ++j) { const unsigned c = xb_ld(&bar[XB_XCNT(j)]); sum += c; cnt += (c > 0u) ? 1u : 0u; mine = (j == x) ? c : mine; }
        if (sum == G) break;
        __builtin_amdgcn_s_sleep(1);
        if ((++sp & 255u) == 0u) { if (xb_ld(&bar[XB_TMO])) break; if (sp > XB_SPIN_CAP) { atomicAdd(&bar[XB_TMO], 1u); break; } }
    }
    nloc = mine > 0u ? mine : 1u; nx = cnt > 0u ? cnt : 1u;
}

__device__ __forceinline__ void xcd_barrier(const XcdBarrier& b) {
    asm volatile("s_waitcnt vmcnt(0)" ::: "memory");
    __syncthreads();
    if (threadIdx.x == 0) {
        unsigned* bar = b.bar;
        __builtin_amdgcn_s_waitcnt(0);
        unsigned nloc = b.st[0], nx = b.st[1];
        if (nloc == 0u) { xcd_barrier_complete(bar, b.x, nloc, nx); b.st[0] = nloc; b.st[1] = nx; }
        const unsigned old = xb_add(&bar[XB_XSUB(b.x)], 1u);
        const unsigned gen = old / nloc;
        if (old + 1u == (gen + 1u) * nloc) {
            __builtin_amdgcn_fence(__ATOMIC_RELEASE, "agent");
            asm volatile("s_waitcnt vmcnt(0)" ::: "memory");
            const unsigned og = xb_add(&bar[XB_TOP], 1u);
            const unsigned tg = og / nx;
            if (og + 1u == (tg + 1u) * nx) xb_add(&bar[XB_TOPGEN], 1u);
            else XB_SPIN(xb_ld(&bar[XB_TOPGEN]) == tg, bar);
            __builtin_amdgcn_fence(__ATOMIC_ACQUIRE, "agent");
            xb_add(&bar[XB_XGEN(b.x)], 1u);
            asm volatile("s_waitcnt vmcnt(0)" ::: "memory");
        } else {
            XB_SPIN(xb_ld(&bar[XB_XGEN(b.x)]) == gen, bar);
            __builtin_amdgcn_fence(__ATOMIC_ACQUIRE, "agent");
            asm volatile("s_waitcnt vmcnt(0)" ::: "memory");
        }
    }
    __syncthreads();
}

__device__ __forceinline__ void group_barrier(unsigned* ctl, int c, unsigned target, volatile LAS unsigned* st) {
    asm volatile("s_waitcnt vmcnt(0)" ::: "memory");
    __syncthreads();
    if (threadIdx.x == 0) {
        __builtin_amdgcn_s_waitcnt(0);
        unsigned same = st[0];
        if (same == 0u) { const unsigned i0 = xb_ld(&ctl[CW_XID + (c & 63)]), i1 = xb_ld(&ctl[CW_XID + (c & 63) + 64]), i2 = xb_ld(&ctl[CW_XID + (c & 63) + 128]), i3 = xb_ld(&ctl[CW_XID + (c & 63) + 192]);
            same = (i0 != 0u && i0 == i1 && i0 == i2 && i0 == i3) ? 1u : 2u; st[0] = same; }
        unsigned* w = &ctl[CW_GB + 64 * (c & 63)];
        if (same != 1u) { __builtin_amdgcn_fence(__ATOMIC_RELEASE, "agent"); asm volatile("s_waitcnt vmcnt(0)" ::: "memory"); }
        (void)xb_add(w, 1u);
        XB_SPIN(xb_ld(w) < target, ctl + CW_BAR);
        __builtin_amdgcn_fence(__ATOMIC_ACQUIRE, "agent");
        asm volatile("s_waitcnt vmcnt(0)" ::: "memory");
    }
    __syncthreads();
}

__device__ __forceinline__ void batch_barrier(unsigned* ctl, int c, unsigned target, volatile LAS unsigned* st) {
    asm volatile("s_waitcnt vmcnt(0)" ::: "memory");
    __syncthreads();
    if (threadIdx.x == 0) {
        __builtin_amdgcn_s_waitcnt(0);
        unsigned same = st[0];
        if (same == 0u) { const unsigned i0 = xb_ld(&ctl[CW_XID + (c & 7)]); bool eq = (i0 != 0u);
            for (int j = 1; j < 32; ++j) eq = eq && (xb_ld(&ctl[CW_XID + (c & 7) + 8 * j]) == i0);
            same = eq ? 1u : 2u; st[0] = same; }
        unsigned* w = &ctl[CW_BB + 64 * (c & 7)];
        if (same != 1u) { __builtin_amdgcn_fence(__ATOMIC_RELEASE, "agent"); asm volatile("s_waitcnt vmcnt(0)" ::: "memory"); }
        (void)xb_add(w, 1u);
        XB_SPIN(xb_ld(w) < target, ctl + CW_BAR);
        __builtin_amdgcn_fence(__ATOMIC_ACQUIRE, "agent");
        asm volatile("s_waitcnt vmcnt(0)" ::: "memory");
    }
    __syncthreads();
}

struct Frame {
    LAS unsigned char* lds;
    unsigned char* ws;
    int tid, lane, wave, G, vcu;
};
__device__ __forceinline__ Frame fresh(const Frame& F) {
    Frame R = F; int t = F.tid; asm volatile("" : "+v"(t)); unsigned long long w = (unsigned long long)F.ws; asm volatile("" : "+s"(w));
    R.tid = t; R.lane = t & 63; R.wave = __builtin_amdgcn_readfirstlane(t >> 6); R.ws = (unsigned char*)w; return R; }
#define CAS __attribute__((address_space(4)))
struct Args { const float* in[16]; float* out; unsigned char* ws; int ph_lo, ph_hi; };

__device__ __forceinline__ void decode_unit(int L, int nM, int nN, int& pm, int& pn) {
    const int nwg = nM * nN;
    int wgid = L; { const int q = nwg / 8, r = nwg % 8, xcd = wgid % 8, off = wgid / 8; wgid = (xcd < r ? xcd * (q + 1) : r * (q + 1) + (xcd - r) * q) + off; }
    const int nig = 8 * nN, gid = wgid / nig, fm = gid * 8, gsz = (nM - fm) < 8 ? (nM - fm) : 8;
    pm = fm + ((wgid % nig) % gsz); pn = (wgid % nig) / gsz;
}
struct PlainOrder {
    int nM, nN, G, c, aoff, boff;
    __device__ __forceinline__ bool next(int i, pg8::Unit& u) const {
        const long L = (long)i * G + c; if (L >= (long)nM * nN) return false;
        int pm, pn; decode_unit((int)L, nM, nN, pm, pn); u.pm = aoff + pm; u.pn = boff + pn; return true; }
    __device__ __forceinline__ void a_ready(const pg8::Unit&) const {}
    __device__ __forceinline__ void done(const pg8::Unit&) const {}
};
struct ProjOrder {
    int G, c, hA0, wB0;
    __device__ __forceinline__ bool next(int i, pg8::Unit& u) const {
        const long L = (long)i * G + c; if (L >= 64L * NPT) return false;
        int pm, pn; decode_unit((int)L, 64, NPT, pm, pn);
        if (pn == 17) { u.pm = wB0 + 17; u.pn = hA0 + pm; } else { u.pm = hA0 + pm; u.pn = wB0 + pn; }
        return true; }
    __device__ __forceinline__ void a_ready(const pg8::Unit&) const {}
    __device__ __forceinline__ void done(const pg8::Unit&) const {}
};
struct MoeOrder {
    int G, c, nN, Tm, t1, t2, t3, t4, t5, t6, t7, sparseA;
    int limit = 0x7fffffff;
    __device__ __forceinline__ int expert_of(int pm) const { return (pm >= t1) + (pm >= t2) + (pm >= t3) + (pm >= t4) + (pm >= t5) + (pm >= t6) + (pm >= t7); }
    __device__ __forceinline__ int first_of(int e) const { return e == 0 ? 0 : (e == 1 ? t1 : (e == 2 ? t2 : (e == 3 ? t3 : (e == 4 ? t4 : (e == 5 ? t5 : (e == 6 ? t6 : t7)))))); }
    __device__ __forceinline__ bool next(int i, pg8::Unit& u) const {
        const long L = (long)i * G + c; if (L >= (long)Tm * nN || L >= limit) return false;
        return unit_of((int)L, u); }
    __device__ __forceinline__ bool unit_of(int L, pg8::Unit& u) const {
        int pm, pn; decode_unit(L, Tm, nN, pm, pn); const int e = expert_of(pm), sp = e * ECAPT + (pm - first_of(e));
        u.pm = sparseA ? sp : pm; u.aux = sparseA ? pm : sp; u.pn = e * nN + pn; return true; }
    __device__ __forceinline__ void a_ready(const pg8::Unit&) const {}
    __device__ __forceinline__ void done(const pg8::Unit&) const {}
};

struct MoeTailOrder {
    MoeOrder M; int first, R, S;
    __device__ __forceinline__ bool next(int i, pg8::Unit& u) const {
        if (i > 0 || M.c >= R * S) return false;
        M.unit_of(first + M.c / S, u); u.ks = M.c % S; return true; }
    __device__ __forceinline__ void a_ready(const pg8::Unit&) const {}
    __device__ __forceinline__ void done(const pg8::Unit&) const {}
};
__device__ __forceinline__ int tail_slices(int R) { return R == 0 ? 1 : (R * 14 <= 256 ? 14 : (R * 7 <= 256 ? 7 : (R * 4 <= 256 ? 4 : (R * 2 <= 256 ? 2 : 1)))); }
typedef const pg8::f32x4 (&AccRef)[2][2][4][2];
__device__ __forceinline__ v4u pack8(f32x4 a, f32x4 b) { v4u w; w.x = pk2(a[0], a[1]); w.y = pk2(a[2], a[3]); w.z = pk2(b[0], b[1]); w.w = pk2(b[2], b[3]); return w; }
__device__ __forceinline__ void unpack8(v4u w, f32x4& a, f32x4& b) { a = (f32x4){bflo(w.x), bfhi(w.x), bflo(w.y), bfhi(w.y)}; b = (f32x4){bflo(w.z), bfhi(w.z), bflo(w.w), bfhi(w.w)}; }

struct EpiProj {
    static constexpr bool PERM = true, AFTER_DRAIN = false, NOT_IDEMPOTENT = false, HAS_MID = false; static constexpr int NST = 0;
    unsigned char* ws; int hA0, wB0; const LAS float* rstd;
    __device__ __forceinline__ void operator()(AccRef acc, const pg8::Unit& u, int wr, int wc, int fr, int fq) const {
        bf16* base; int ldc, mode = 0, rowbase; const bool vt = (u.pm >= wB0 && u.pm < wB0 + NPT);
        if (vt) { base = (bf16*)(ws + WS_VT) + (size_t)(u.pn - hA0) * 256; ldc = NTOK; rowbase = 0; }
        else {
            const int ct = u.pn - wB0; rowbase = (u.pm - hA0) * 256;
            if (ct < 12) { base = (bf16*)(ws + WS_BCU) + ct * 256; ldc = 3072; }
            else if (ct < 16) { base = (bf16*)(ws + WS_Q) + (ct - 12) * 256; ldc = 1024; }
            else if (ct == 16) { base = (bf16*)(ws + WS_K); ldc = 256; }
            else if (ct < 22) { base = (bf16*)(ws + WS_QI) + (ct - 18) * 256; ldc = 1024; }
            else if (ct < 38) { base = (bf16*)(ws + WS_GT) + (ct - 22) * 128; ldc = 4096; mode = 1; }
            else { base = (bf16*)(ws + WS_KW); ldc = 256; }
        }
        const int row0 = rowbase + wr * 64 + fr, col0 = wc * 32 + 8 * fq;
#pragma unroll
        for (int ai = 0; ai < 2; ++ai)
#pragma unroll
            for (int m = 0; m < 4; ++m) { bf16* rowp = base + (size_t)(row0 + ai * 128 + m * 16) * ldc + col0;
                const float rs = (rstd && !vt) ? rstd[ai * 128 + wr * 64 + m * 16 + fr] : 1.0f;
                if (mode) {
                    f32x4 r0, r1, a0, a1; const float nl = -1.4426950408889634f * rs;
#pragma unroll
                    for (int j = 0; j < 4; ++j) { const float ea0 = 1.0f + fast_exp2(acc[ai][0][m][0][j] * nl), eb0 = 1.0f + fast_exp2(acc[ai][1][m][0][j] * nl), ea1 = 1.0f + fast_exp2(acc[ai][0][m][1][j] * nl), eb1 = 1.0f + fast_exp2(acc[ai][1][m][1][j] * nl);
                        a0[j] = __builtin_amdgcn_rcpf(eb0); a1[j] = __builtin_amdgcn_rcpf(eb1); r0[j] = eb0 * __builtin_amdgcn_rcpf(ea0); r1[j] = eb1 * __builtin_amdgcn_rcpf(ea1); }
                    *(GAS v4u*)(rowp) = pack8(r0, r1); *(GAS v4u*)(rowp + 2048) = pack8(a0, a1);
                } else {
#pragma unroll
                for (int bj = 0; bj < 2; ++bj) { f32x4 v0 = acc[ai][bj][m][0] * rs, v1 = acc[ai][bj][m][1] * rs;
                    if (rstd && vt) { const LAS f32x4* rp = (const LAS f32x4*)(rstd + bj * 128 + wc * 32 + 8 * fq); v0 = v0 * rp[0]; v1 = v1 * rp[1]; }
                    *(GAS v4u*)(rowp + bj * 128) = pack8(v0, v1); } } }
    }
};
template <int MODE  > struct EpiGate {
    static constexpr bool PERM = true, AFTER_DRAIN = false, NOT_IDEMPOTENT = (MODE == 1), HAS_MID = false; static constexpr int NST = 0;
    unsigned char* ws;
    __device__ __forceinline__ void operator()(AccRef acc, const pg8::Unit& u, int wr, int wc, int fr, int fq) const {
        const int row0 = u.pm * 256 + wr * 64 + fr, col0 = u.pn * 256 + wc * 32 + 8 * fq;
        bf16* Z = (bf16*)(ws + WS_Z); const bf16* GT = (const bf16*)(ws + WS_GT) + MODE * 2048;
#pragma unroll
        for (int ai = 0; ai < 2; ++ai)
#pragma unroll
            for (int m = 0; m < 4; ++m) { const size_t r = (size_t)(row0 + ai * 128 + m * 16);
#pragma unroll
                for (int bj = 0; bj < 2; ++bj) { const int c = col0 + bj * 128;
                    f32x4 g0, g1; unpack8(*(const GAS v4u*)(GT + r * 4096 + c), g0, g1);
                    f32x4 v0 = acc[ai][bj][m][0] * g0, v1 = acc[ai][bj][m][1] * g1;
                    if (MODE == 1) { f32x4 z0, z1; unpack8(*(const GAS v4u*)(Z + r * 2048 + c), z0, z1); v0 = v0 + z0; v1 = v1 + z1; }
                    *(GAS v4u*)(Z + r * 2048 + c) = pack8(v0, v1); } }
    }
};
struct EpiMix {
    static constexpr bool PERM = true, AFTER_DRAIN = false, NOT_IDEMPOTENT = false, HAS_MID = true; static constexpr int NST = 0;
    unsigned char* ws;
    __device__ __forceinline__ void mid(pg8::f32x4 (&acc)[2][2][4][2], const pg8::Unit& u, int wr, int wc, int fr, int fq) const {
        const int row0 = u.pm * 256 + wr * 64 + fr, col0 = u.pn * 256 + wc * 32 + 8 * fq; const bf16* GT = (const bf16*)(ws + WS_GT);
        v4u cv[2][4][2];
#pragma unroll
        for (int ai = 0; ai < 2; ++ai)
#pragma unroll
            for (int m = 0; m < 4; ++m)
#pragma unroll
                for (int bj = 0; bj < 2; ++bj) cv[ai][m][bj] = *(const GAS v4u*)(GT + (size_t)(row0 + ai * 128 + m * 16) * 4096 + col0 + bj * 128);
        __builtin_amdgcn_sched_barrier(0);
#pragma unroll
        for (int ai = 0; ai < 2; ++ai)
#pragma unroll
            for (int m = 0; m < 4; ++m)
#pragma unroll
                for (int bj = 0; bj < 2; ++bj) { f32x4 c0, c1; unpack8(cv[ai][m][bj], c0, c1); acc[ai][bj][m][0] = acc[ai][bj][m][0] * c0; acc[ai][bj][m][1] = acc[ai][bj][m][1] * c1; }
        __builtin_amdgcn_sched_barrier(0);
    }
    __device__ __forceinline__ void operator()(AccRef acc, const pg8::Unit& u, int wr, int wc, int fr, int fq) const {
        const int row0 = u.pm * 256 + wr * 64 + fr, col0 = u.pn * 256 + wc * 32 + 8 * fq;
        bf16* Z = (bf16*)(ws + WS_Z); const bf16* GT = (const bf16*)(ws + WS_GT) + 2048;
#pragma unroll
        for (int ai = 0; ai < 2; ++ai) { v4u gv[4][2];
#pragma unroll
            for (int m = 0; m < 4; ++m)
#pragma unroll
                for (int bj = 0; bj < 2; ++bj) gv[m][bj] = *(const GAS v4u*)(GT + (size_t)(row0 + ai * 128 + m * 16) * 4096 + col0 + bj * 128);
            __builtin_amdgcn_sched_barrier(0);
#pragma unroll
            for (int m = 0; m < 4; ++m)
#pragma unroll
                for (int bj = 0; bj < 2; ++bj) { f32x4 g0, g1; unpack8(gv[m][bj], g0, g1);
                    *(GAS v4u*)(Z + (size_t)(row0 + ai * 128 + m * 16) * 2048 + col0 + bj * 128) = pack8(acc[ai][bj][m][0] * g0, acc[ai][bj][m][1] * g1); }
            __builtin_amdgcn_sched_barrier(0); }
    }
};
template <bool RES16, bool OUT16> struct EpiRes {
    static constexpr bool PERM = RES16 && OUT16, AFTER_DRAIN = false, NOT_IDEMPOTENT = false, HAS_MID = false; static constexpr int NST = 0;
    const void* res; void* out; float scale; const float* rg;
    __device__ __forceinline__ void operator()(AccRef acc, const pg8::Unit& u, int wr, int wc, int fr, int fq) const {
      if constexpr (PERM) {
        const int row0 = u.pm * 256 + wr * 64 + fr, col0 = u.pn * 256 + wc * 32 + 8 * fq;
        f32x4 gi[2][2];
#pragma unroll
        for (int bj = 0; bj < 2; ++bj)
#pragma unroll
            for (int n = 0; n < 2; ++n) { gi[bj][n] = (f32x4){1.f, 1.f, 1.f, 1.f}; if (rg) { const f32x4 t = *(const GAS f32x4*)(rg + col0 + bj * 128 + n * 4); gi[bj][n] = (f32x4){__builtin_amdgcn_rcpf(t.x), __builtin_amdgcn_rcpf(t.y), __builtin_amdgcn_rcpf(t.z), __builtin_amdgcn_rcpf(t.w)}; } }
#pragma unroll
        for (int ai = 0; ai < 2; ++ai) { v4u rv[4][2];
#pragma unroll
            for (int m = 0; m < 4; ++m)
#pragma unroll
                for (int bj = 0; bj < 2; ++bj) rv[m][bj] = *(const GAS v4u*)((const bf16*)res + (size_t)(row0 + ai * 128 + m * 16) * 2048 + col0 + bj * 128);
            __builtin_amdgcn_sched_barrier(0);
#pragma unroll
            for (int m = 0; m < 4; ++m)
#pragma unroll
                for (int bj = 0; bj < 2; ++bj) { f32x4 r0, r1; unpack8(rv[m][bj], r0, r1);
                    *(GAS v4u*)((bf16*)out + (size_t)(row0 + ai * 128 + m * 16) * 2048 + col0 + bj * 128) = pack8(r0 * gi[bj][0] + acc[ai][bj][m][0] * scale, r1 * gi[bj][1] + acc[ai][bj][m][1] * scale); }
            __builtin_amdgcn_sched_barrier(0); }
      } else {
        const int row0 = u.pm * 256 + wr * 64 + fr, col0 = u.pn * 256 + wc * 32 + 4 * fq;
        f32x4 gi[2][2];
#pragma unroll
        for (int bj = 0; bj < 2; ++bj)
#pragma unroll
            for (int n = 0; n < 2; ++n) { gi[bj][n] = (f32x4){1.f, 1.f, 1.f, 1.f}; if (rg) { const f32x4 t = *(const GAS f32x4*)(rg + col0 + bj * 128 + n * 16); gi[bj][n] = (f32x4){1.f / t.x, 1.f / t.y, 1.f / t.z, 1.f / t.w}; } }
#pragma unroll
        for (int ai = 0; ai < 2; ++ai)
#pragma unroll
            for (int m = 0; m < 4; ++m) { const size_t o = (size_t)(row0 + ai * 128 + m * 16) * 2048 + col0;
#pragma unroll
                for (int bj = 0; bj < 2; ++bj)
#pragma unroll
                    for (int n = 0; n < 2; ++n) { const size_t oo = o + bj * 128 + n * 16; f32x4 r;
                        if constexpr (RES16) { const v2u w = *(const GAS v2u*)((const bf16*)res + oo); r = (f32x4){bflo(w.x), bfhi(w.x), bflo(w.y), bfhi(w.y)}; } else r = *(const GAS f32x4*)((const float*)res + oo);
                        const f32x4 v = r * gi[bj][n] + acc[ai][bj][m][n] * scale;
                        if constexpr (OUT16) { v2u w; w.x = pk2(v.x, v.y); w.y = pk2(v.z, v.w); *(GAS v2u*)((bf16*)out + oo) = w; } else *(GAS f32x4*)((float*)out + oo) = v; } }
      }
    }
};
template <bool F8OUT, bool RES16, bool OUT16> struct EpiRes2 {
    static constexpr bool PERM = RES16 && OUT16, AFTER_DRAIN = false, NOT_IDEMPOTENT = false, HAS_MID = false; static constexpr int NST = 0;
    const void* res; void* out; float scale; const float* g; void* Hn; float* slab; const float* rg; const float* rrow;
    __device__ __forceinline__ void operator()(AccRef acc, const pg8::Unit& u, int wr, int wc, int fr, int fq) const {
      if constexpr (PERM) {
        const int row0 = u.pm * 256 + wr * 64 + fr, col0 = u.pn * 256 + wc * 32 + 8 * fq;
        f32x4 gv[2][2], gi[2][2];
#pragma unroll
        for (int bj = 0; bj < 2; ++bj)
#pragma unroll
            for (int n = 0; n < 2; ++n) { gi[bj][n] = (f32x4){1.f, 1.f, 1.f, 1.f}; if (rg) { const f32x4 t = *(const GAS f32x4*)(rg + col0 + bj * 128 + n * 4); gi[bj][n] = (f32x4){__builtin_amdgcn_rcpf(t.x), __builtin_amdgcn_rcpf(t.y), __builtin_amdgcn_rcpf(t.z), __builtin_amdgcn_rcpf(t.w)}; }
                gv[bj][n] = *(const GAS f32x4*)(g + col0 + bj * 128 + n * 4) * (F8OUT ? F8_SA : 1.0f); }
#pragma unroll
        for (int ai = 0; ai < 2; ++ai) { v4u rv[4][2]; float rr[4];
#pragma unroll
            for (int m = 0; m < 4; ++m) { const int row = row0 + ai * 128 + m * 16; rr[m] = rrow ? rrow[row] : 1.0f;
#pragma unroll
                for (int bj = 0; bj < 2; ++bj) rv[m][bj] = *(const GAS v4u*)((const bf16*)res + (size_t)row * 2048 + col0 + bj * 128); }
            __builtin_amdgcn_sched_barrier(0);
#pragma unroll
            for (int m = 0; m < 4; ++m) { const int row = row0 + ai * 128 + m * 16; float ss = 0.f;
#pragma unroll
                for (int bj = 0; bj < 2; ++bj) { const size_t oo = (size_t)row * 2048 + col0 + bj * 128; f32x4 r0, r1; unpack8(rv[m][bj], r0, r1);
                    const f32x4 v0 = r0 * gi[bj][0] * rr[m] + acc[ai][bj][m][0] * scale, v1 = r1 * gi[bj][1] * rr[m] + acc[ai][bj][m][1] * scale;
                    if (out) *(GAS v4u*)((bf16*)out + oo) = pack8(v0, v1);
                    ss += ((v0.x * v0.x + v0.y * v0.y) + (v0.z * v0.z + v0.w * v0.w)) + ((v1.x * v1.x + v1.y * v1.y) + (v1.z * v1.z + v1.w * v1.w));
                    const f32x4 h0 = v0 * gv[bj][0], h1 = v1 * gv[bj][1];
                    if constexpr (F8OUT) { v2u w; w.x = pk4_fp8(h0.x, h0.y, h0.z, h0.w); w.y = pk4_fp8(h1.x, h1.y, h1.z, h1.w); *(GAS v2u*)((unsigned char*)Hn + oo) = w; }
                    else *(GAS v4u*)((bf16*)Hn + oo) = pack8(h0, h1); }
                ss += __shfl_xor(ss, 16); ss += __shfl_xor(ss, 32);
                if (fq == 0) slab[(size_t)(u.pn * 4 + wc) * NTOK + row] = ss; }
            __builtin_amdgcn_sched_barrier(0); }
      } else {
        const int row0 = u.pm * 256 + wr * 64 + fr, col0 = u.pn * 256 + wc * 32 + 4 * fq;
        f32x4 gv[2][2], gi[2][2];
#pragma unroll
        for (int bj = 0; bj < 2; ++bj)
#pragma unroll
            for (int n = 0; n < 2; ++n) { gi[bj][n] = (f32x4){1.f, 1.f, 1.f, 1.f}; if (rg) { const f32x4 t = *(const GAS f32x4*)(rg + col0 + bj * 128 + n * 16); gi[bj][n] = (f32x4){1.f / t.x, 1.f / t.y, 1.f / t.z, 1.f / t.w}; } }
#pragma unroll
        for (int bj = 0; bj < 2; ++bj)
#pragma unroll
            for (int n = 0; n < 2; ++n) gv[bj][n] = *(const GAS f32x4*)(g + col0 + bj * 128 + n * 16) * (F8OUT ? F8_SA : 1.0f);
#pragma unroll
        for (int ai = 0; ai < 2; ++ai)
#pragma unroll
            for (int m = 0; m < 4; ++m) { const int row = row0 + ai * 128 + m * 16; const size_t o = (size_t)row * 2048 + col0; float ss = 0.f; const float rr = rrow ? rrow[row] : 1.0f;
#pragma unroll
                for (int bj = 0; bj < 2; ++bj)
#pragma unroll
                    for (int n = 0; n < 2; ++n) { const size_t oo = o + bj * 128 + n * 16; f32x4 r;
                        if constexpr (RES16) { const v2u w = *(const GAS v2u*)((const bf16*)res + oo); r = (f32x4){bflo(w.x), bfhi(w.x), bflo(w.y), bfhi(w.y)}; } else r = *(const GAS f32x4*)((const float*)res + oo);
                        const f32x4 v = r * gi[bj][n] * rr + acc[ai][bj][m][n] * scale;
                        if (out) { if constexpr (OUT16) { v2u w; w.x = pk2(v.x, v.y); w.y = pk2(v.z, v.w); *(GAS v2u*)((bf16*)out + oo) = w; } else *(GAS f32x4*)((float*)out + oo) = v; }
                        ss += (v.x * v.x + v.y * v.y) + (v.z * v.z + v.w * v.w);
                        const f32x4 h = v * gv[bj][n];
                        if constexpr (F8OUT) *(GAS unsigned*)((unsigned char*)Hn + oo) = pk4_fp8(h.x, h.y, h.z, h.w);
                        else { v2u w; w.x = pk2(h.x, h.y); w.y = pk2(h.z, h.w); *(GAS v2u*)((bf16*)Hn + oo) = w; } }
                ss += __shfl_xor(ss, 16); ss += __shfl_xor(ss, 32);
                if (fq == 0) slab[(size_t)(u.pn * 4 + wc) * NTOK + row] = ss; }
      }
    }
};
__device__ __forceinline__ int fixed_panel(int c) { return 8 * (c & 7) + ((c >> 3) & 7); }
__device__ __forceinline__ void rstd_table(const Frame& F, const float* slab, int pm) {
    LAS float* tab = (LAS float*)(F.lds + RSTD_OFF);
    if (F.tid < 256) { const GAS float* p = (const GAS float*)slab + (size_t)pm * 256 + F.tid; float s = 0.f;
#pragma unroll
        for (int k = 0; k < 32; ++k) s += p[(size_t)k * NTOK];
        tab[F.tid] = 1.0f / sqrtf(s * (1.f / D) + RMS_EPS); }
    __syncthreads();
}
struct EpiSwiglu {
    static constexpr bool PERM = true, AFTER_DRAIN = false, NOT_IDEMPOTENT = false, HAS_MID = false; static constexpr int NST = 0;
    bf16* out; int ldc, ntile;
    __device__ __forceinline__ void operator()(AccRef acc, const pg8::Unit& u, int wr, int wc, int fr, int fq) const {
        const int row0 = u.pm * 256 + wr * 64 + fr, col0 = (u.pn % ntile) * 128 + wc * 32 + 8 * fq;
#pragma unroll
        for (int ai = 0; ai < 2; ++ai)
#pragma unroll
            for (int m = 0; m < 4; ++m) { f32x4 v0, v1;
#pragma unroll
                for (int j = 0; j < 4; ++j) { v0[j] = siluf_(acc[ai][0][m][0][j]) * acc[ai][1][m][0][j]; v1[j] = siluf_(acc[ai][0][m][1][j]) * acc[ai][1][m][1][j]; }
                *(GAS v4u*)(out + (size_t)(row0 + ai * 128 + m * 16) * ldc + col0) = pack8(v0, v1); }
    }
};
struct EpiSwigluF8 {
    static constexpr bool PERM = true, AFTER_DRAIN = false, NOT_IDEMPOTENT = false, HAS_MID = false; static constexpr int NST = 0;
    unsigned char* out; int ldc, ntile; const LAS float* rstd; int use_aux;
    __device__ __forceinline__ void operator()(AccRef acc, const pg8::Unit& u, int wr, int wc, int fr, int fq) const {
        const int row0 = (use_aux ? u.aux : u.pm) * 256 + wr * 64 + fr, col0 = (u.pn % ntile) * 128 + wc * 32 + 8 * fq; const float si0 = 1.0f / (F8_SA * F8_SW);
#pragma unroll
        for (int ai = 0; ai < 2; ++ai)
#pragma unroll
            for (int m = 0; m < 4; ++m) { float v[8]; const float si = rstd ? si0 * rstd[ai * 128 + wr * 64 + m * 16 + fr] : si0;
                const float c1 = -1.4426950408889634f * si, k2 = si * si * F8_SACT;
#pragma unroll
                for (int n = 0; n < 2; ++n)
#pragma unroll
                    for (int jj = 0; jj < 2; ++jj) { const f32x2 a = {acc[ai][0][m][n][2 * jj], acc[ai][0][m][n][2 * jj + 1]}, b = {acc[ai][1][m][n][2 * jj], acc[ai][1][m][n][2 * jj + 1]};
                        const f32x2 t = a * c1; f32x2 d = {fast_exp2(t.x), fast_exp2(t.y)}; d = d + 1.0f; const f32x2 r = {__builtin_amdgcn_rcpf(d.x), __builtin_amdgcn_rcpf(d.y)};
                        const f32x2 vv = ((a * b) * k2) * r; v[4 * n + 2 * jj] = vv.x; v[4 * n + 2 * jj + 1] = vv.y; }
                v2u o; o.x = pk4_fp8(v[0], v[1], v[2], v[3]); o.y = pk4_fp8(v[4], v[5], v[6], v[7]);
                *(GAS v2u*)(out + (size_t)(row0 + ai * 128 + m * 16) * ldc + col0) = o; }
    }
};
struct EpiPartial {
    static constexpr bool PERM = true, AFTER_DRAIN = false, NOT_IDEMPOTENT = false, HAS_MID = false; static constexpr int NST = 0;
    float* part;
    __device__ __forceinline__ void operator()(AccRef acc, const pg8::Unit&, int wr, int wc, int fr, int fq) const {
        const int row0 = wr * 64 + fr, col0 = wc * 32 + 8 * fq;
#pragma unroll
        for (int ai = 0; ai < 2; ++ai)
#pragma unroll
            for (int m = 0; m < 4; ++m) { float* rp = part + (size_t)(row0 + ai * 128 + m * 16) * 256 + col0;
#pragma unroll
                for (int bj = 0; bj < 2; ++bj) { *(GAS f32x4*)(rp + bj * 128) = acc[ai][bj][m][0]; *(GAS f32x4*)(rp + bj * 128 + 4) = acc[ai][bj][m][1]; } }
    }
};
struct EpiMoeDown {
    static constexpr bool PERM = true, AFTER_DRAIN = false, NOT_IDEMPOTENT = false, HAS_MID = false; static constexpr int NST = 0;
    unsigned char* ws;
    __device__ __forceinline__ void operator()(AccRef acc, const pg8::Unit& u, int wr, int wc, int fr, int fq) const {
        const int row0 = u.aux * 256 + wr * 64 + fr, col0 = (u.pn & 7) * 256 + wc * 32 + 8 * fq;
        const int* rowtok = (const int*)(ws + WS_ROWTOK); const float* roww = (const float*)(ws + WS_ROWW); bf16* Y = (bf16*)(ws + WS_XB);
        int tk[2][4]; float w[2][4];
#pragma unroll
        for (int ai = 0; ai < 2; ++ai)
#pragma unroll
            for (int m = 0; m < 4; ++m) { const int r = row0 + ai * 128 + m * 16; tk[ai][m] = rowtok[r]; w[ai][m] = roww[r]; }
        __builtin_amdgcn_sched_barrier(0);
#pragma unroll
        for (int ai = 0; ai < 2; ++ai)
#pragma unroll
            for (int m = 0; m < 4; ++m) { const float ws_ = w[ai][m] * (1.0f / (F8_SACT * F8_SW));
                if (tk[ai][m] >= 0) {
#pragma unroll
                    for (int bj = 0; bj < 2; ++bj) *(GAS v4u*)(Y + (size_t)tk[ai][m] * 2048 + col0 + bj * 128) = pack8(acc[ai][bj][m][0] * ws_, acc[ai][bj][m][1] * ws_); } }
    }
};

template <int MAP> __device__ __forceinline__ int map_row(int n) {
    if (MAP == 0) return n;
    if (MAP == 1) { if (n < 5632) return n; if (n < 5696) return n + (9728 - 5632); if (n < 5712) return n + (9792 - 5696);
        const int ng = n - 5712, br = ng >> 11, ch = ng & 2047; return 5632 + (ch >> 7) * 256 + br * 128 + (ch & 127); }
    if (MAP == 2) return (n >> 7) * 256 + (n & 127);
    return (n >> 7) * 256 + 128 + (n & 127);
}
__device__ __forceinline__ float rms_row(const float* xrow, const float* g, bf16* orow, int lane, f32x4 (&v)[8]) {
    const GAS f32x4* xr = (const GAS f32x4*)xrow + lane; float s = 0.f;
#pragma unroll
    for (int j = 0; j < 8; ++j) { v[j] = xr[64 * j]; s += (v[j].x * v[j].x + v[j].y * v[j].y) + (v[j].z * v[j].z + v[j].w * v[j].w); }
    const float rstd = 1.0f / sqrtf(wave_sum(s) * (1.f / D) + RMS_EPS);
    const GAS f32x4* gr = (const GAS f32x4*)g + lane; GAS v2u* o8 = (GAS v2u*)orow + lane;
#pragma unroll
    for (int j = 0; j < 8; ++j) { v[j] = v[j] * rstd * gr[64 * j]; v2u o; o.x = pk2(v[j].x, v[j].y); o.y = pk2(v[j].z, v[j].w); o8[64 * j] = o; }
    return rstd;
}
__device__ __forceinline__ void rms_pass_f8(const Frame& F, const float* x, const float* g, unsigned char* H) {
    const int gw = F.vcu * NWAVES + F.wave, NGW = F.G * NWAVES, lane = F.lane;
    for (int m = gw; m < NTOK; m += NGW) {
        const GAS f32x4* xr = (const GAS f32x4*)(x + (size_t)m * D) + lane; f32x4 v[8]; float s = 0.f;
#pragma unroll
        for (int j = 0; j < 8; ++j) { v[j] = xr[64 * j]; s += (v[j].x * v[j].x + v[j].y * v[j].y) + (v[j].z * v[j].z + v[j].w * v[j].w); }
        const float rstd = F8_SA / sqrtf(wave_sum(s) * (1.f / D) + RMS_EPS);
        const GAS f32x4* gr = (const GAS f32x4*)g + lane; GAS unsigned* o4 = (GAS unsigned*)(H + (size_t)m * D) + lane;
#pragma unroll
        for (int j = 0; j < 8; ++j) { const f32x4 t = v[j] * rstd * gr[64 * j]; o4[64 * j] = pk4_fp8(t.x, t.y, t.z, t.w); }
    }
}
__device__ __forceinline__ void rms_pass(const Frame& F, const float* x, const float* g, bf16* H, float* rms_out = nullptr) {
    const int gw = F.vcu * NWAVES + F.wave, NGW = F.G * NWAVES; f32x4 v[8];
    for (int m = gw; m < NTOK; m += NGW) { const float rstd = rms_row(x + (size_t)m * D, g, H + (size_t)m * D, F.lane, v); if (rms_out && F.lane == 0) rms_out[m] = 1.0f / rstd; }
}
#define CAS __attribute__((address_space(4)))
struct CvtItem { const float* W; unsigned char* WT; int K, N, k0, n0, map, f8, ldk; };
constexpr int I_IN = 32 * 154, I_C = 16 * 32, I_O = 32 * 32, I_F1 = 32 * 88, I_F2 = 88 * 32, I_E1 = 32 * 112, I_E2 = 112 * 32;
constexpr int CB0 = 0, CB1 = CB0 + 2 * I_IN, CB2 = CB1 + 2 * I_C, CB3 = CB2 + 2 * I_C, CB4 = CB3 + 2 * I_O, CB5 = CB4 + I_F1, CB6 = CB5 + I_F1, CB7 = CB6 + I_F2,
              CB8 = CB7 + 8 * I_E1, CB9 = CB8 + 8 * I_E1, CB10 = CB9 + 8 * I_E2;
constexpr int CBX = CB7 + (int)((long)(CB10 - CB7) * CONV_PROLOGUE_PCT / 100), CBS2 = CB10 - (int)((long)(CB10 - CB7) * CONV_S2_PCT / 100), CBS1 = CBS2 - (int)((long)(CB10 - CB7) * CONV_S1_PCT / 100);
__device__ __forceinline__ CvtItem cvt_decode(const CAS Args* ap, unsigned char* ws, int it) {
    CvtItem d; int item;
    if (it >= CB9) { const int r = it - CB9, e = r / I_E2; d.W = ap->in[14] + (size_t)e * FFE * D; d.K = FFE; d.N = D; d.WT = ws + WS_EW2 + (size_t)e * D * FFE; d.map = 0; d.f8 = 1; item = r - e * I_E2; }
    else if (it >= CB8) { const int r = it - CB8, e = r / I_E1; d.W = ap->in[13] + (size_t)e * D * FFE; d.K = D; d.N = FFE; d.WT = ws + WS_EW13 + (size_t)e * 2 * FFE * D; d.map = 3; d.f8 = 1; item = r - e * I_E1; }
    else if (it >= CB7) { const int r = it - CB7, e = r / I_E1; d.W = ap->in[12] + (size_t)e * D * FFE; d.K = D; d.N = FFE; d.WT = ws + WS_EW13 + (size_t)e * 2 * FFE * D; d.map = 2; d.f8 = 1; item = r - e * I_E1; }
    else if (it >= CB6) { d.W = ap->in[10]; d.K = FF; d.N = D; d.WT = ws + WS_W2; d.map = 0; d.f8 = F8_FFN; item = it - CB6; }
    else if (it >= CB5) { d.W = ap->in[9]; d.K = D; d.N = FF; d.WT = ws + WS_W13; d.map = 3; d.f8 = F8_FFN; item = it - CB5; }
    else if (it >= CB4) { d.W = ap->in[8]; d.K = D; d.N = FF; d.WT = ws + WS_W13; d.map = 2; d.f8 = F8_FFN; item = it - CB4; }
    else if (it >= CB3) { const int r = it - CB3, l = r / I_O; d.W = ap->in[6] + (size_t)l * D * D; d.K = D; d.N = D; d.WT = ws + WS_WO + (size_t)l * D * D * 2; d.map = 0; d.f8 = 0; item = r - l * I_O; }
    else if (it >= CB2) { const int r = it - CB2, l = r / I_C; d.W = ap->in[5] + (size_t)l * 1024 * D; d.K = 1024; d.N = D; d.WT = ws + WS_WC + (size_t)l * D * D * 2 + 1024 * 2; d.map = 0; d.f8 = 0; item = r - l * I_C; }
    else if (it >= CB1) { const int r = it - CB1, l = r / I_C; d.W = ap->in[4] + (size_t)l * 1024 * D; d.K = 1024; d.N = D; d.WT = ws + WS_WC + (size_t)l * D * D * 2; d.map = 0; d.f8 = 0; item = r - l * I_C; }
    else { const int l = it / I_IN; d.W = ap->in[2] + (size_t)l * D * INC; d.K = D; d.N = INC; d.WT = ws + (l ? WS_W1 : WS_W0); d.map = 1; d.f8 = 0; item = it - l * I_IN; }
    const int nblk = (d.N + 63) >> 6, kb = item / nblk, nb = item - kb * nblk; d.k0 = 64 * kb; d.n0 = 64 * nb;
    d.ldk = (it >= CB1 && it < CB3) ? 2048 : d.K;
    return d;
}
__device__ __forceinline__ int map_row_rt(int map, int n) { return map == 0 ? n : (map == 1 ? map_row<1>(n) : (map == 2 ? map_row<2>(n) : map_row<3>(n))); }
__device__ __forceinline__ void cvt_load(const CvtItem& d, f32x4 (&v)[16], int lane) {
    const int r = lane >> 4, q = lane & 15; const bool ld_ok = (d.n0 + 4 * q) < d.N;
    const GAS float* p = (const GAS float*)d.W + (size_t)(d.k0 + r) * d.N + d.n0 + 4 * q;
#pragma unroll
    for (int i = 0; i < 16; ++i) v[i] = ld_ok ? __builtin_nontemporal_load((const GAS f32x4*)(p + (size_t)(4 * i) * d.N)) : (f32x4){0.f, 0.f, 0.f, 0.f};
}
__device__ __forceinline__ void cvt_store(const CvtItem& d, f32x4 (&v)[16], LAS unsigned char* scr, int lane) {
#pragma unroll
    for (int i = 0; i < 16; ++i) {
        const float f0 = v[i][0], f1 = v[i][1], f2 = v[i][2], f3 = v[i][3];
        unsigned a0 = __builtin_bit_cast(unsigned, f0), a1 = __builtin_bit_cast(unsigned, f1), a2 = __builtin_bit_cast(unsigned, f2), a3 = __builtin_bit_cast(unsigned, f3);
        { auto t = __builtin_amdgcn_permlane16_swap(a0, a1, false, false); a0 = t[0]; a1 = t[1]; }
        { auto t = __builtin_amdgcn_permlane16_swap(a2, a3, false, false); a2 = t[0]; a3 = t[1]; }
        { auto t = __builtin_amdgcn_permlane32_swap(a0, a2, false, false); a0 = t[0]; a2 = t[1]; }
        { auto t = __builtin_amdgcn_permlane32_swap(a1, a3, false, false); a1 = t[0]; a3 = t[1]; }
        v[i] = (f32x4){__builtin_bit_cast(float, a0), __builtin_bit_cast(float, a1), __builtin_bit_cast(float, a2), __builtin_bit_cast(float, a3)};
    }
    LAS unsigned char* my = scr + lane * 144;
    if (d.f8) {
#pragma unroll
        for (int p = 0; p < 4; ++p) { v4u o; o.x = pk4_fp8(v[4 * p][0] * F8_SW, v[4 * p][1] * F8_SW, v[4 * p][2] * F8_SW, v[4 * p][3] * F8_SW); o.y = pk4_fp8(v[4 * p + 1][0] * F8_SW, v[4 * p + 1][1] * F8_SW, v[4 * p + 1][2] * F8_SW, v[4 * p + 1][3] * F8_SW);
            o.z = pk4_fp8(v[4 * p + 2][0] * F8_SW, v[4 * p + 2][1] * F8_SW, v[4 * p + 2][2] * F8_SW, v[4 * p + 2][3] * F8_SW); o.w = pk4_fp8(v[4 * p + 3][0] * F8_SW, v[4 * p + 3][1] * F8_SW, v[4 * p + 3][2] * F8_SW, v[4 * p + 3][3] * F8_SW); *(LAS v4u*)(my + 16 * p) = o; }
        LDS_WAIT(); asm volatile("" ::: "memory");
#pragma unroll
        for (int jj = 0; jj < 4; ++jj) { const int s_ = 16 * jj + (lane >> 2), c = lane & 3, n = d.n0 + 4 * (s_ & 15) + (s_ >> 4);
            const v4u o = *(const LAS v4u*)(scr + s_ * 144 + 16 * c);
            if (n < d.N) __builtin_nontemporal_store(o, (GAS v4u*)(d.WT + (size_t)map_row_rt(d.map, n) * d.ldk + d.k0 + 16 * c)); }
    } else {
#pragma unroll
        for (int p = 0; p < 8; ++p) *(LAS v4u*)(my + 16 * p) = pack8(v[2 * p], v[2 * p + 1]);
        LDS_WAIT(); asm volatile("" ::: "memory");
#pragma unroll
        for (int jj = 0; jj < 8; ++jj) { const int s_ = 8 * jj + (lane >> 3), c = lane & 7, n = d.n0 + 4 * (s_ & 15) + (s_ >> 4);
            const v4u o = *(const LAS v4u*)(scr + s_ * 144 + 16 * c);
            if (n < d.N) __builtin_nontemporal_store(o, (GAS v4u*)(d.WT + ((size_t)map_row_rt(d.map, n) * d.ldk + d.k0 + 8 * c) * 2)); }
    }
    LDS_WAIT(); asm volatile("" ::: "memory");
}
__device__ __forceinline__ void convert_items(const Frame& F, const CAS Args* ap, int gw, int NGW, int it_lo, int it_hi) {
    unsigned char* ws = F.ws; LAS unsigned char* scr = F.lds + F.wave * 16384; const int lane = F.lane;
    int it = it_lo + gw; if (it >= it_hi) return;
    f32x4 va[16], vb[16];
    CvtItem da = cvt_decode(ap, ws, it), db = da; cvt_load(da, va, lane);
    for (;;) {
        const int it1 = it + NGW; const bool has1 = it1 < it_hi;
        if (has1) { db = cvt_decode(ap, ws, it1); cvt_load(db, vb, lane); }
        cvt_store(da, va, scr, lane);
        if (!has1) break;
        const int it2 = it1 + NGW; const bool has2 = it2 < it_hi;
        if (has2) { da = cvt_decode(ap, ws, it2); cvt_load(da, va, lane); }
        cvt_store(db, vb, scr, lane);
        if (!has2) break;
        it = it2;
    }
}
template <int KIND> struct XW {
    static constexpr int K = KIND == 2 ? FFE : D, N = KIND == 2 ? D : FFE, NBLK = N / 64, IE = (K / 64) * NBLK, BASE = KIND == 0 ? CB7 : (KIND == 1 ? CB8 : CB9), END = KIND == 0 ? CB8 : (KIND == 1 ? CB9 : CB10);
};
template <int KIND> __device__ __forceinline__ void xw_load(const CAS Args* ap, int it, f32x4 (&v)[16], int lane) {
    typedef XW<KIND> X; const int r = it - X::BASE, e = r / X::IE, item = r - e * X::IE, kb = item / X::NBLK, nb = item - kb * X::NBLK;
    const GAS float* p = (const GAS float*)(ap->in[KIND == 0 ? 12 : (KIND == 1 ? 13 : 14)]) + (size_t)e * X::K * X::N + (size_t)(64 * kb + (lane >> 4)) * X::N + 64 * nb + 4 * (lane & 15);
#pragma unroll
    for (int i = 0; i < 16; ++i) v[i] = __builtin_nontemporal_load((const GAS f32x4*)(p + (size_t)(4 * i) * X::N));
}
template <int KIND> __device__ __forceinline__ void xw_store(unsigned char* ws, int it, f32x4 (&v)[16], LAS unsigned char* scr, int lane) {
    typedef XW<KIND> X; const int r = it - X::BASE, e = r / X::IE, item = r - e * X::IE, kb = item / X::NBLK, nb = item - kb * X::NBLK;
    unsigned char* dst = ws + (KIND == 2 ? WS_EW2 + (size_t)e * D * FFE : WS_EW13 + (size_t)e * 2 * FFE * D) + 64 * kb;
    unsigned a[16][4];
#pragma unroll
    for (int i = 0; i < 16; ++i) { const float f0 = v[i][0], f1 = v[i][1], f2 = v[i][2], f3 = v[i][3];
        a[i][0] = __builtin_bit_cast(unsigned, f0); a[i][1] = __builtin_bit_cast(unsigned, f1); a[i][2] = __builtin_bit_cast(unsigned, f2); a[i][3] = __builtin_bit_cast(unsigned, f3); }
#pragma unroll
    for (int i = 0; i < 16; ++i) {
        { auto t = __builtin_amdgcn_permlane16_swap(a[i][0], a[i][1], false, false); a[i][0] = t[0]; a[i][1] = t[1]; }
        { auto t = __builtin_amdgcn_permlane16_swap(a[i][2], a[i][3], false, false); a[i][2] = t[0]; a[i][3] = t[1]; } }
    __builtin_amdgcn_sched_barrier(0);
#pragma unroll
    for (int i = 0; i < 16; ++i) {
        { auto t = __builtin_amdgcn_permlane32_swap(a[i][0], a[i][2], false, false); a[i][0] = t[0]; a[i][2] = t[1]; }
        { auto t = __builtin_amdgcn_permlane32_swap(a[i][1], a[i][3], false, false); a[i][1] = t[0]; a[i][3] = t[1]; } }
    __builtin_amdgcn_sched_barrier(0);
#pragma unroll
    for (int i = 0; i < 16; ++i) v[i] = (f32x4){__builtin_bit_cast(float, a[i][0]), __builtin_bit_cast(float, a[i][1]), __builtin_bit_cast(float, a[i][2]), __builtin_bit_cast(float, a[i][3])} * F8_SW;
    LAS unsigned char* my = scr + lane * 144;
#pragma unroll
    for (int p = 0; p < 4; ++p) { v4u o; o.x = pk4_fp8(v[4 * p][0], v[4 * p][1], v[4 * p][2], v[4 * p][3]); o.y = pk4_fp8(v[4 * p + 1][0], v[4 * p + 1][1], v[4 * p + 1][2], v[4 * p + 1][3]);
        o.z = pk4_fp8(v[4 * p + 2][0], v[4 * p + 2][1], v[4 * p + 2][2], v[4 * p + 2][3]); o.w = pk4_fp8(v[4 * p + 3][0], v[4 * p + 3][1], v[4 * p + 3][2], v[4 * p + 3][3]); *(LAS v4u*)(my + 16 * p) = o; }
    LDS_WAIT(); asm volatile("" ::: "memory");
#pragma unroll
    for (int jj = 0; jj < 4; ++jj) { const int s_ = 16 * jj + (lane >> 2), c = lane & 3, n = 64 * nb + 4 * (s_ & 15) + (s_ >> 4);
        const int row = KIND == 2 ? n : ((n >> 7) * 256 + (KIND == 1 ? 128 : 0) + (n & 127));
        const v4u o = *(const LAS v4u*)(scr + s_ * 144 + 16 * c);
        __builtin_nontemporal_store(o, (GAS v4u*)(dst + (size_t)row * X::K + 16 * c)); }
    LDS_WAIT(); asm volatile("" ::: "memory");
}
template <int KIND> __device__ __forceinline__ void xw_run(const Frame& F, const CAS Args* ap, int gw, int NGW, int it_lo, int it_hi) {
    typedef XW<KIND> X; const int lo = it_lo > X::BASE ? it_lo : X::BASE, hi = it_hi < X::END ? it_hi : X::END;
    int it = it_lo + gw; if (it < lo) it += ((lo - it + NGW - 1) / NGW) * NGW;
    if (it >= hi) return;
    unsigned char* ws = F.ws; LAS unsigned char* scr = F.lds + F.wave * 16384; const int lane = F.lane;
    f32x4 va[16], vb[16];
    xw_load<KIND>(ap, it, va, lane);
    for (;;) {
        const int it1 = it + NGW; const bool has1 = it1 < hi;
        if (has1) xw_load<KIND>(ap, it1, vb, lane);
        xw_store<KIND>(ws, it, va, scr, lane);
        if (!has1) break;
        const int it2 = it1 + NGW; const bool has2 = it2 < hi;
        if (has2) xw_load<KIND>(ap, it2, va, lane);
        xw_store<KIND>(ws, it1, vb, scr, lane);
        if (!has2) break;
        it = it2;
    }
}
__device__ __forceinline__ void convert_expert_items(const Frame& F, const CAS Args* ap, int gw, int NGW, int it_lo, int it_hi) {
    xw_run<0>(F, ap, gw, NGW, it_lo, it_hi); xw_run<1>(F, ap, gw, NGW, it_lo, it_hi); xw_run<2>(F, ap, gw, NGW, it_lo, it_hi);
}
constexpr int XB_IE = 448, XB_KIND = 8 * XB_IE, XB_TOTAL = 3 * XB_KIND, XB_TILE = 256 * 144;
template <int KIND> __device__ __forceinline__ void xb_load(const CAS Args* ap, int bit, f32x4 (&v)[16], int wave, int lane) {
    constexpr int K = KIND == 2 ? FFE : D, N = KIND == 2 ? D : FFE, NB = N / 256;
    const int e = bit / XB_IE, item = bit - e * XB_IE, kb = item / NB, nb = item - kb * NB;
    const GAS float* p = (const GAS float*)(ap->in[12 + KIND]) + (size_t)e * K * N + (size_t)(128 * kb + 16 * wave) * N + 256 * nb + 4 * lane;
#pragma unroll
    for (int i = 0; i < 16; ++i) v[i] = __builtin_nontemporal_load((const GAS f32x4*)(p + (size_t)i * N));
}
template <int KIND> __device__ __forceinline__ void xb_store(unsigned char* ws, int bit, f32x4 (&v)[16], LAS unsigned char* tile, int wave, int lane) {
    constexpr int K = KIND == 2 ? FFE : D, N = KIND == 2 ? D : FFE, NB = N / 256;
    const int e = bit / XB_IE, item = bit - e * XB_IE, kb = item / NB, nb = item - kb * NB;
    unsigned char* dst = ws + (KIND == 2 ? WS_EW2 + (size_t)e * D * FFE : WS_EW13 + (size_t)e * 2 * FFE * D) + 128 * kb;
#pragma unroll
    for (int i = 0; i < 16; ++i) v[i] = v[i] * F8_SW;
#pragma unroll
    for (int j = 0; j < 4; ++j) { v4u o; o.x = pk4_fp8(v[0][j], v[1][j], v[2][j], v[3][j]); o.y = pk4_fp8(v[4][j], v[5][j], v[6][j], v[7][j]); o.z = pk4_fp8(v[8][j], v[9][j], v[10][j], v[11][j]); o.w = pk4_fp8(v[12][j], v[13][j], v[14][j], v[15][j]);
        *(LAS v4u*)(tile + (4 * lane + j) * 144 + 16 * (wave ^ ((lane >> 2) & 3))) = o; }
    __syncthreads();
#pragma unroll
    for (int t = 0; t < 4; ++t) { const int row = 32 * wave + 8 * t + (lane >> 3), c = lane & 7, n = 256 * nb + row;
        const v4u o = *(const LAS v4u*)(tile + row * 144 + 16 * (c ^ ((row >> 4) & 3)));
        const int rowm = KIND == 2 ? n : ((n >> 7) * 256 + (KIND == 1 ? 128 : 0) + (n & 127));
        __builtin_nontemporal_store(o, (GAS v4u*)(dst + (size_t)rowm * K + 16 * c)); }
}
template <int KIND> __device__ __forceinline__ void xb_run(const Frame& F, const CAS Args* ap, int rank, int ncu, int lo, int hi, int& par) {
    const int klo = KIND * XB_KIND, khi = klo + XB_KIND, a = lo > klo ? lo : klo, b = hi < khi ? hi : khi;
    int it = lo + rank; if (it < a) it += ((a - it + ncu - 1) / ncu) * ncu;
    if (it >= b) return;
    unsigned char* ws = F.ws; const int lane = F.lane, wave = F.wave;
    f32x4 va[16], vb[16];
    xb_load<KIND>(ap, it - klo, va, wave, lane);
    for (;;) {
        const int it1 = it + ncu; const bool has1 = it1 < b;
        if (has1) xb_load<KIND>(ap, it1 - klo, vb, wave, lane);
        xb_store<KIND>(ws, it - klo, va, F.lds + (par & 1) * XB_TILE, wave, lane); ++par;
        if (!has1) break;
        const int it2 = it1 + ncu; const bool has2 = it2 < b;
        if (has2) xb_load<KIND>(ap, it2 - klo, va, wave, lane);
        xb_store<KIND>(ws, it1 - klo, vb, F.lds + (par & 1) * XB_TILE, wave, lane); ++par;
        if (!has2) break;
        it = it2;
    }
}
__device__ __forceinline__ void convert_expert_blocks(const Frame& F, const CAS Args* ap, int rank, int ncu, int lo, int hi) {
    int par = 0; __syncthreads();
    xb_run<0>(F, ap, rank, ncu, lo, hi, par); xb_run<1>(F, ap, rank, ncu, lo, hi, par); xb_run<2>(F, ap, rank, ncu, lo, hi, par);
    __syncthreads();
}
__device__ __forceinline__ void prologue(const Frame& F, const CAS Args* ap) {
    const int gw = F.vcu * NWAVES + F.wave, NGW = F.G * NWAVES;
    unsigned char* ws = F.ws;
    if (NCONV > 0 && F.G == 256) { convert_items(F, ap, gw, NGW, 0, I_IN); convert_items(F, ap, gw, NGW, CB1, CBX); }
    else convert_items(F, ap, gw, NGW, 0, CB10);
    { const int gt = (F.vcu * NTHR + F.tid), NT = F.G * NTHR; constexpr int PADV = (INP - INC) * D * 2 / 16;
      for (int i = gt; i < 2 * PADV; i += NT) { const int l = i / PADV, r = i - l * PADV; ((GAS v4u*)(ws + (l ? WS_W1 : WS_W0) + (size_t)INC * D * 2))[r] = (v4u){0u, 0u, 0u, 0u}; } }
    { int* rowtok = (int*)(ws + WS_ROWTOK); for (int i = F.vcu * NTHR + F.tid; i < 8 * ECAP; i += F.G * NTHR) rowtok[i] = -1; }
    rms_pass(F, ap->in[0], ap->in[1], (bf16*)(ws + WS_H), (float*)(ws + WS_RMS0));
}

__device__ __forceinline__ void conv_phase(const Frame& F, const float* convw  , int rank, int nwg) {
    const bf16* BCU = (const bf16*)(F.ws + WS_BCU); bf16* Y = (bf16*)(F.ws + WS_YMIX);
    for (int it = rank * NTHR + F.tid; it < (NTOK / 16) * 128; it += nwg * NTHR) {
        const int chunk = it & 127, t0 = (it >> 7) * 16, ch0 = chunk * 8;
        f32x4 w0a = *(const GAS f32x4*)(convw + ch0), w0b = *(const GAS f32x4*)(convw + ch0 + 4);
        f32x4 w1a = *(const GAS f32x4*)(convw + 1024 + ch0), w1b = *(const GAS f32x4*)(convw + 1024 + ch0 + 4);
        f32x4 w2a = *(const GAS f32x4*)(convw + 2048 + ch0), w2b = *(const GAS f32x4*)(convw + 2048 + ch0 + 4);
        f32x4 p2a = {0.f, 0.f, 0.f, 0.f}, p2b = p2a, p1a = p2a, p1b = p2a;
        if ((t0 & (T - 1)) != 0) {
            f32x4 ca, cb, ua, ub;
            unpack8(*(const GAS v4u*)(BCU + (size_t)(t0 - 2) * 3072 + 1024 + ch0), ca, cb); unpack8(*(const GAS v4u*)(BCU + (size_t)(t0 - 2) * 3072 + 2048 + ch0), ua, ub); p2a = ca * ua; p2b = cb * ub;
            unpack8(*(const GAS v4u*)(BCU + (size_t)(t0 - 1) * 3072 + 1024 + ch0), ca, cb); unpack8(*(const GAS v4u*)(BCU + (size_t)(t0 - 1) * 3072 + 2048 + ch0), ua, ub); p1a = ca * ua; p1b = cb * ub;
        }
#pragma unroll
        for (int hb = 0; hb < 2; ++hb) { v4u lb[8], lc[8], lu[8];
#pragma unroll
            for (int i = 0; i < 8; ++i) { const size_t r = (size_t)(t0 + hb * 8 + i) * 3072; lb[i] = *(const GAS v4u*)(BCU + r + ch0); lc[i] = *(const GAS v4u*)(BCU + r + 1024 + ch0); lu[i] = *(const GAS v4u*)(BCU + r + 2048 + ch0); }
            __builtin_amdgcn_sched_barrier(0);
#pragma unroll
            for (int i = 0; i < 8; ++i) { f32x4 ba, bb, ca, cb, ua, ub;
                unpack8(lb[i], ba, bb); unpack8(lc[i], ca, cb); unpack8(lu[i], ua, ub);
                const f32x4 va = ca * ua, vb = cb * ub;
                const f32x4 ya = ba * (w0a * p2a + w1a * p1a + w2a * va), yb = bb * (w0b * p2b + w1b * p1b + w2b * vb);
                *(GAS v4u*)(Y + (size_t)(t0 + hb * 8 + i) * 2048 + ch0) = pack8(ya, yb);
                p2a = p1a; p2b = p1b; p1a = va; p1b = vb; }
            __builtin_amdgcn_sched_barrier(0); }
    }
}

constexpr int IX_BUF = 128 * 128, IX_RING = 4;
#define GLDS16(sbase, vo, ldsaddr) asm volatile("s_mov_b32 m0, %2\n\ts_nop 0\n\tglobal_load_lds_dwordx4 %0, %1" :: "v"(vo), "s"(sbase), "s"(ldsaddr) : "memory")
#define dpp_i(x, ctrl) __builtin_amdgcn_mov_dpp((x), (ctrl), 0xF, 0xF, true)
__device__ __forceinline__ int half_sum(int x, int lane) {
    x += dpp_i(x, 0xB1); x += dpp_i(x, 0x4E); x += dpp_i(x, 0x141); x += dpp_i(x, 0x140);
    auto t = __builtin_amdgcn_permlane16_swap((unsigned)x, (unsigned)x, false, false); return x + (int)(((lane >> 4) & 1) ? t[0] : t[1]);
}
__device__ __forceinline__ unsigned half_umax(unsigned x, int lane) {
    unsigned y;
    y = (unsigned)dpp_i((int)x, 0xB1); x = x > y ? x : y; y = (unsigned)dpp_i((int)x, 0x4E); x = x > y ? x : y; y = (unsigned)dpp_i((int)x, 0x141); x = x > y ? x : y; y = (unsigned)dpp_i((int)x, 0x140); x = x > y ? x : y;
    auto t = __builtin_amdgcn_permlane16_swap(x, x, false, false); y = ((lane >> 4) & 1) ? t[0] : t[1]; return x > y ? x : y;
}
__device__ __forceinline__ void indexer_unit(const Frame& F, int b, int tg) {
    LAS unsigned char* lds = F.lds;
    const int lane = F.lane, c = lane & 31, hi = lane >> 5, tid = F.tid;
    const int tA = tg * 16 + 2 * F.wave, tme = tA + hi;
    const int ntile = ((tA + 1) >> 5) + 1;
    const int nchunk = ((tg * 16 + 15) >> 7) + 1;
    const bf16* QI = (const bf16*)(F.ws + WS_QI); const bf16* KW = (const bf16*)(F.ws + WS_KW);
    const int atok = tA + ((c >> 2) & 1), ahead = (c >> 3) * 4 + (c & 3);
    const GAS bf16x8* qp = (const GAS bf16x8*)(QI + ((size_t)(b * T + atok) * 1024 + ahead * 64 + 8 * hi));
    bf16x8 qa[4];
#pragma unroll
    for (int kk = 0; kk < 4; ++kk) qa[kk] = qp[2 * kk];
    float w[16];
    { const GAS v4u* wp = (const GAS v4u*)(KW + (size_t)(b * T + tme) * 256 + 64); const v4u w0 = wp[0], w1 = wp[1];
      w[0] = bflo(w0.x); w[1] = bfhi(w0.x); w[2] = bflo(w0.y); w[3] = bfhi(w0.y); w[4] = bflo(w0.z); w[5] = bfhi(w0.z); w[6] = bflo(w0.w); w[7] = bfhi(w0.w);
      w[8] = bflo(w1.x); w[9] = bfhi(w1.x); w[10] = bflo(w1.y); w[11] = bfhi(w1.y); w[12] = bflo(w1.z); w[13] = bfhi(w1.z); w[14] = bflo(w1.w); w[15] = bfhi(w1.w); }
    const int wv = F.wave;
    unsigned dvo[2];
#pragma unroll
    for (int jj = 0; jj < 2; ++jj) { const int row = (wv * 2 + jj) * 8 + (lane >> 3), slot = lane & 7; dvo[jj] = (unsigned)((row * 256 + ((slot ^ ((row >> 1) & 7)) * 8)) * 2); }
    const char* kbase = (const char*)(KW + (size_t)(b * T) * 256);
    const unsigned ldsb = (unsigned)__builtin_amdgcn_readfirstlane((int)((unsigned)(size_t)lds + (unsigned)wv * 2048u));
#define IX_ISSUE(chn) do { const char* sb_ = kbase + (size_t)(chn) * 128 * 512; const unsigned la_ = ldsb + (unsigned)(((chn) % IX_RING) * IX_BUF); \
        GLDS16(sb_, dvo[0], la_); GLDS16(sb_, dvo[1], la_ + 1024u); } while (0)
    int roff[4];
#pragma unroll
    for (int kk = 0; kk < 4; ++kk) roff[kk] = c * 128 + (((2 * kk + hi) ^ ((c >> 1) & 7)) << 4);
    unsigned S[64];
    int dcm = tme - c; asm volatile("" : "+v"(dcm));
    const unsigned UNEG = 0x007FFFFFu;
    unsigned umax = UNEG;
    __syncthreads();
#pragma unroll
    for (int p = 0; p < IX_RING - 1; ++p) if (p < nchunk) IX_ISSUE(p);
#pragma unroll
    for (int ch = 0; ch < 16; ++ch) {
        if (ch < nchunk) {
            if (ch + IX_RING - 2 < nchunk) asm volatile("s_waitcnt vmcnt(%0)" :: "n"(2 * (IX_RING - 2)) : "memory"); else asm volatile("s_waitcnt vmcnt(0)" ::: "memory");
            __syncthreads();
            if (ch + IX_RING - 1 < nchunk) IX_ISSUE(ch + IX_RING - 1);
            LAS unsigned char* buf = lds + (ch % IX_RING) * IX_BUF;
#pragma unroll
            for (int i = 0; i < 4; ++i) { const int jt = ch * 4 + i;
                unsigned uk = UNEG;
                if (jt < ntile) {
                    bf16x8 kq[4];
#pragma unroll
                    for (int kk = 0; kk < 4; ++kk) kq[kk] = *(const LAS bf16x8*)(buf + roff[kk] + i * 32 * 128);
                    f32x16 acc;
#pragma unroll
                    for (int r = 0; r < 16; ++r) acc[r] = 0.f;
#pragma unroll
                    for (int kk = 0; kk < 4; ++kk) acc = __builtin_amdgcn_mfma_f32_32x32x16_bf16(qa[kk], kq[kk], acc, 0, 0, 0);
                    float ss = 0.f;
#pragma unroll
                    for (int r = 0; r < 16; ++r) ss = fmaf(w[r], __builtin_amdgcn_fmed3f(acc[r], 0.f, 3.0e38f), ss);
                    const unsigned bits = __builtin_bit_cast(unsigned, ss);
                    const unsigned k2 = bits ^ (((int)bits < 0) ? 0xFFFFFFFFu : 0x80000000u);
                    uk = (32 * jt > dcm) ? UNEG : k2;
                    umax = uk > umax ? uk : umax;
                }
                S[jt] = uk; }
        } else {
#pragma unroll
            for (int i = 0; i < 4; ++i) S[ch * 4 + i] = UNEG;
        }
    }
#undef IX_ISSUE
    unsigned lo = 0x00800000u, hi_ = half_umax(umax, lane) + 1u;
    bool active = (tme + 1) > TOPK;
    for (int it = 0; it < 34; ++it) {
        if (__ballot(active) == 0ull) break;
        const unsigned mid = lo + ((hi_ - lo) >> 1);
        int cnt = 0; int nt2 = ntile; asm volatile("" : "+s"(nt2));
#pragma unroll
        for (int g = 0; g < 8; ++g)
            if (g * 8 < nt2) {
                bool c_[8];
#pragma unroll
                for (int i = 0; i < 8; ++i) c_[i] = S[g * 8 + i] >= mid;
                __builtin_amdgcn_sched_barrier(0);
#pragma unroll
                for (int i = 0; i < 8; ++i) cnt += c_[i] ? 1 : 0;
                __builtin_amdgcn_sched_barrier(0); }
        cnt = half_sum(cnt, lane);
        if (active) { if (cnt >= TOPK) lo = mid; else hi_ = mid; if (cnt == TOPK || hi_ - lo <= 1u) active = false; }
    }
    unsigned mA = 0u, mB = 0u;
#pragma unroll
    for (int g = 0; g < 8; ++g)
        if (g * 8 < ntile) {
#pragma unroll
            for (int i = 0; i < 8; ++i) { const int jt = g * 8 + i; const unsigned long long bal = __ballot(S[jt] >= lo);
                const unsigned blo = (unsigned)bal, bhi = (unsigned)(bal >> 32);
                asm("s_nop 3\n\tv_writelane_b32 %0, %2, %4\n\tv_writelane_b32 %1, %3, %4" : "+v"(mA), "+v"(mB) : "s"(blo), "s"(bhi), "i"(jt)); }
            __builtin_amdgcn_sched_barrier(0); }
    GAS unsigned* MK = (GAS unsigned*)(F.ws + WS_MASK);
    MK[(size_t)(b * T + tA) * 64 + lane] = mA; MK[(size_t)(b * T + tA + 1) * 64 + lane] = mB;
}
__device__ __forceinline__ int wq_next(const Frame& F, gu32* head, int limit) {
    LAS int* slot = (LAS int*)(F.lds + QSLOT_OFF);
    __syncthreads();
    if (F.tid == 0) *slot = (int)__hip_atomic_fetch_add(head, 1u, RLX_AGENT);
    __syncthreads();
    const int u = __builtin_amdgcn_readfirstlane(*slot); return u < limit ? u : -1;
}
__device__ __forceinline__ void indexer_phase(const Frame& F, bool dyn, gu32* head, int v0) {
    int v = v0, k = 0;
#pragma unroll 1
    for (;;) { int b, tg;
        if (dyn) { const int u = wq_next(F, head, 1024); if (u < 0) break; b = u & 7; tg = 127 - (u >> 3); }
        else { if (k == 4) { k = 0; v += F.G; } if (v >= 256) break; const int j = v >> 3; b = v & 7; tg = (k & 2 ? 64 : 0) + ((k & 1) ? 63 - j : j); ++k; }
        indexer_unit(F, b, tg); }
}

constexpr int AT_KROW = 272, AT_VROW = 144, AT_KBYTES = 64 * AT_KROW, AT_BUF = AT_KBYTES + 128 * AT_VROW;
__device__ __forceinline__ void attn_unit(const Frame& F, int b, int g, int blk) {
    LAS unsigned char* lds = F.lds;
    const int lane = F.lane, c = lane & 31, hi = lane >> 5, w = F.wave, tid = F.tid;
    const int head = g * 4 + (w & 3), tq = blk * 64 + (w >> 2) * 32 + c;
    const bf16* Qb = (const bf16*)(F.ws + WS_Q); const bf16* Kb = (const bf16*)(F.ws + WS_K); const bf16* VT = (const bf16*)(F.ws + WS_VT);
    const GAS bf16x8* qp = (const GAS bf16x8*)(Qb + (size_t)(b * T + tq) * 1024 + head * 128 + 8 * hi);
    bf16x8 qf[8];
#pragma unroll
    for (int kk = 0; kk < 8; ++kk) qf[kk] = qp[2 * kk];
    f32x16 O[4];
#pragma unroll
    for (int d = 0; d < 4; ++d)
#pragma unroll
        for (int r = 0; r < 16; ++r) O[d][r] = 0.f;
    float m = -1e30f, l = 0.f;
    const GAS unsigned* mrow = (const GAS unsigned*)(F.ws + WS_MASK) + (size_t)(b * T + tq) * 64;
    const float C2 = 1.4426950408889634f * 0.08838834764831845f;
    const float NEG = -__builtin_inff();
    const int ntiles = blk + 1;
    const int kr0 = tid >> 4, kc0 = tid & 15, vr0 = tid >> 3, vc0 = tid & 7;
    const GAS v4u* kg = (const GAS v4u*)(Kb + (size_t)(b * T + kr0) * 256 + g * 128 + kc0 * 8);
    const GAS v4u* vg = (const GAS v4u*)(VT + (size_t)(g * 128 + vr0) * NTOK + b * T + vc0 * 8);
    v4u kreg0 = kg[0], kreg1 = kg[32 * 256 / 8], vreg0 = vg[0], vreg1 = vg[(size_t)64 * NTOK / 8];
    const int krow = (c & 19) | ((c & 4) << 1) | ((c & 8) >> 1);
    __syncthreads();
    bf16x8 pf[4];
    { const v4u z = {0u, 0u, 0u, 0u};
#pragma unroll
      for (int ks = 0; ks < 4; ++ks) pf[ks] = __builtin_bit_cast(bf16x8, z); }
    int bcur = 0, bprev = 0;
    for (int jt = 0; jt < ntiles; ++jt) {
        LAS unsigned char* kb_ = lds + bcur * AT_BUF; LAS unsigned char* vb_ = kb_ + AT_KBYTES;
        LAS unsigned char* vprev = jt == 0 ? kb_ : lds + bprev * AT_BUF + AT_KBYTES;
        *(LAS v4u*)(kb_ + kr0 * AT_KROW + kc0 * 16) = kreg0; *(LAS v4u*)(kb_ + (kr0 + 32) * AT_KROW + kc0 * 16) = kreg1;
        *(LAS v4u*)(vb_ + vr0 * AT_VROW + vc0 * 16) = vreg0; *(LAS v4u*)(vb_ + (vr0 + 64) * AT_VROW + vc0 * 16) = vreg1;
        const unsigned mw0 = mrow[2 * jt], mw1 = mrow[2 * jt + 1];
        __syncthreads();
        if (jt + 1 < ntiles) { const size_t ko = (size_t)(jt + 1) * 64 * 256 / 8, vo = (size_t)(jt + 1) * 64 / 8;
            kreg0 = kg[ko]; kreg1 = kg[ko + 32 * 256 / 8]; vreg0 = vg[vo]; vreg1 = vg[vo + (size_t)64 * NTOK / 8]; }
        f32x16 s0, s1;
#pragma unroll
        for (int r = 0; r < 16; ++r) { s0[r] = 0.f; s1[r] = 0.f; }
#pragma unroll
        for (int kk = 0; kk < 8; ++kk) {
            const bf16x8 ka = *(const LAS bf16x8*)(kb_ + krow * AT_KROW + kk * 32 + hi * 16);
            const bf16x8 kc = *(const LAS bf16x8*)(kb_ + (32 + krow) * AT_KROW + kk * 32 + hi * 16);
            s0 = __builtin_amdgcn_mfma_f32_32x32x16_bf16(ka, qf[kk], s0, 0, 0, 0);
            s1 = __builtin_amdgcn_mfma_f32_32x32x16_bf16(kc, qf[kk], s1, 0, 0, 0);
        }
        __builtin_amdgcn_sched_barrier(0);
        const unsigned m0 = mw0 >> (8 * hi), m1 = mw1 >> (8 * hi);
        float pmax = NEG;
#define AT_VFRAG(g) (*(const LAS bf16x8*)(vprev + (32 * ((g) >> 2) + c) * AT_VROW + ((g) & 3) * 32 + hi * 16))
        bf16x8 vnx = AT_VFRAG(0);
#pragma unroll
        for (int g_ = 0; g_ < 8; ++g_) {
            const bf16x8 va = vnx; vnx = AT_VFRAG(g_ + 1);
            O[g_ >> 2] = __builtin_amdgcn_mfma_f32_32x32x16_bf16(va, pf[g_ & 3], O[g_ >> 2], 0, 0, 0);
            __builtin_amdgcn_sched_barrier(0);
#pragma unroll
            for (int r = 2 * g_; r < 2 * g_ + 2; ++r) { const int bit = (r & 7) + 16 * (r >> 3);
                const unsigned k0 = (unsigned)__builtin_amdgcn_sbfe((int)m0, bit, 1), k1 = (unsigned)__builtin_amdgcn_sbfe((int)m1, bit, 1);
                const float f0 = s0[r], f1 = s1[r];
                s0[r] = __builtin_bit_cast(float, (__builtin_bit_cast(unsigned, f0) & k0) | (0xFF800000u & ~k0));
                s1[r] = __builtin_bit_cast(float, (__builtin_bit_cast(unsigned, f1) & k1) | (0xFF800000u & ~k1));
                pmax = fmaxf(pmax, fmaxf(s0[r], s1[r])); }
            __builtin_amdgcn_sched_barrier(0);
        }
        pmax = fmaxf(pmax, __shfl_xor(pmax, 32));
        const float mn = fmaxf(m, pmax), alpha = fast_exp2((m - mn) * C2), mc = mn * C2; m = mn;
        float ps = 0.f;
#pragma unroll
        for (int g_ = 8; g_ < 16; ++g_) {
            const bf16x8 va = vnx; if (g_ < 15) vnx = AT_VFRAG(g_ + 1);
            O[g_ >> 2] = __builtin_amdgcn_mfma_f32_32x32x16_bf16(va, pf[g_ & 3], O[g_ >> 2], 0, 0, 0);
            __builtin_amdgcn_sched_barrier(0);
#pragma unroll
            for (int r = 2 * (g_ - 8); r < 2 * (g_ - 8) + 2; ++r) { s0[r] = fast_exp2(fmaf(s0[r], C2, -mc)); s1[r] = fast_exp2(fmaf(s1[r], C2, -mc)); ps += s0[r] + s1[r]; }
            __builtin_amdgcn_sched_barrier(0);
        }
#undef AT_VFRAG
        l = l * alpha + ps;
        { v4u t; t.x = pk2(s0[0], s0[1]); t.y = pk2(s0[2], s0[3]); t.z = pk2(s0[4], s0[5]); t.w = pk2(s0[6], s0[7]); pf[0] = __builtin_bit_cast(bf16x8, t);
          t.x = pk2(s0[8], s0[9]); t.y = pk2(s0[10], s0[11]); t.z = pk2(s0[12], s0[13]); t.w = pk2(s0[14], s0[15]); pf[1] = __builtin_bit_cast(bf16x8, t);
          t.x = pk2(s1[0], s1[1]); t.y = pk2(s1[2], s1[3]); t.z = pk2(s1[4], s1[5]); t.w = pk2(s1[6], s1[7]); pf[2] = __builtin_bit_cast(bf16x8, t);
          t.x = pk2(s1[8], s1[9]); t.y = pk2(s1[10], s1[11]); t.z = pk2(s1[12], s1[13]); t.w = pk2(s1[14], s1[15]); pf[3] = __builtin_bit_cast(bf16x8, t); }
        __builtin_amdgcn_sched_barrier(0);
        if (__ballot(alpha != 1.0f) != 0ull) {
#pragma unroll
            for (int d = 0; d < 4; ++d)
#pragma unroll
                for (int r = 0; r < 16; ++r) O[d][r] *= alpha; }
        bprev = bcur; bcur = bcur == 2 ? 0 : bcur + 1;
    }
    { LAS unsigned char* vlast = lds + bprev * AT_BUF + AT_KBYTES;
#pragma unroll
      for (int d = 0; d < 4; ++d)
#pragma unroll
        for (int ks = 0; ks < 4; ++ks) {
            const bf16x8 va = *(const LAS bf16x8*)(vlast + (32 * d + c) * AT_VROW + ks * 32 + hi * 16);
            O[d] = __builtin_amdgcn_mfma_f32_32x32x16_bf16(va, pf[ks], O[d], 0, 0, 0); } }
    l += __shfl_xor(l, 32);
    const float inv = 1.0f / l;
    bf16* AO = (bf16*)(F.ws + WS_YMIX) + (size_t)(b * T + tq) * 2048 + 1024 + head * 128;
#pragma unroll
    for (int d = 0; d < 4; ++d)
#pragma unroll
        for (int q4 = 0; q4 < 4; ++q4) { v2u o; o.x = pk2(O[d][4 * q4] * inv, O[d][4 * q4 + 1] * inv); o.y = pk2(O[d][4 * q4 + 2] * inv, O[d][4 * q4 + 3] * inv);
            *(GAS v2u*)(AO + 32 * d + 8 * q4 + 4 * hi) = o; }
}
__device__ __forceinline__ void attn_phase(const Frame& F, bool dyn, gu32* head, int v0) {
    int v = v0, k = 0;
#pragma unroll 1
    for (;;) { int b, g, blk;
        if (dyn) { const int u = wq_next(F, head, 512); if (u < 0) break; b = u & 7; g = (u >> 3) & 1; blk = 31 - (u >> 4); }
        else { if (k == 2) { k = 0; v += F.G; } if (v >= 256) break; const int x = v >> 4; b = v & 7; g = (v >> 3) & 1; blk = k ? x : 31 - x; ++k; }
        attn_unit(F, b, g, blk); }
}

template <bool X16> __device__ __forceinline__ void router_phase(const Frame& F, const void* x, const float* g, const float* rw  ) {
    const int gw = F.vcu * NWAVES + F.wave, NGW = F.G * NWAVES, lane = F.lane;
    gu32* cnt = (gu32*)(F.ws + WS_CTL) + CW_CNT; unsigned char* XIN = (unsigned char*)(F.ws + WS_XIN); int* rowtok = (int*)(F.ws + WS_ROWTOK); float* roww = (float*)(F.ws + WS_ROWW);
    LAS f32x4* rl = (LAS f32x4*)F.lds;
    __syncthreads();
#pragma unroll
    for (int k = 0; k < 8; ++k) { const int i = F.tid + 512 * k, d = i >> 1, half = i & 1; rl[(((d >> 8) * 4 + (d & 3)) * 2 + half) * 64 + ((d & 255) >> 2)] = ((const GAS f32x4*)rw)[i]; }
    f32x4 gg[8];
#pragma unroll
    for (int j = 0; j < 8; ++j) gg[j] = ((const GAS f32x4*)g + lane)[64 * j];
    __syncthreads();
    f32x4 v[8];
    typedef typename std::conditional<X16, v2u, f32x4>::type XV;
    XV xb[8];
    if (gw < NTOK) {
#pragma unroll
        for (int j = 0; j < 8; ++j) xb[j] = ((const GAS XV*)((const char*)x + (size_t)gw * D * sizeof(XV) / 4) + lane)[64 * j]; }
    for (int t = gw; t < NTOK; t += NGW) {
        { float ssq = 0.f;
#pragma unroll
          for (int j = 0; j < 8; ++j) { if constexpr (X16) { const v2u w = xb[j]; v[j] = (f32x4){bflo(w.x), bfhi(w.x), bflo(w.y), bfhi(w.y)}; } else v[j] = xb[j];
            ssq += (v[j].x * v[j].x + v[j].y * v[j].y) + (v[j].z * v[j].z + v[j].w * v[j].w); }
          if (t + NGW < NTOK) {
#pragma unroll
              for (int j = 0; j < 8; ++j) xb[j] = ((const GAS XV*)((const char*)x + (size_t)(t + NGW) * D * sizeof(XV) / 4) + lane)[64 * j]; }
          const float rstd = 1.0f / sqrtf(wave_sum(ssq) * (1.f / D) + RMS_EPS);
#pragma unroll
          for (int j = 0; j < 8; ++j) v[j] = v[j] * rstd * gg[j]; }
        float lg[8];
#pragma unroll
        for (int e = 0; e < 8; ++e) lg[e] = 0.f;
#pragma unroll
        for (int j = 0; j < 8; ++j)
#pragma unroll
            for (int q = 0; q < 4; ++q) { const f32x4 r0 = rl[((j * 4 + q) * 2) * 64 + lane], r1 = rl[((j * 4 + q) * 2 + 1) * 64 + lane]; const float hv = v[j][q];
                lg[0] = fmaf(hv, r0.x, lg[0]); lg[1] = fmaf(hv, r0.y, lg[1]); lg[2] = fmaf(hv, r0.z, lg[2]); lg[3] = fmaf(hv, r0.w, lg[3]);
                lg[4] = fmaf(hv, r1.x, lg[4]); lg[5] = fmaf(hv, r1.y, lg[5]); lg[6] = fmaf(hv, r1.z, lg[6]); lg[7] = fmaf(hv, r1.w, lg[7]);
                if (q == 3) __builtin_amdgcn_sched_barrier(0); }
#pragma unroll
        for (int e = 0; e < 8; ++e) lg[e] = wave_sum(lg[e]);
        int e1 = 0; float v1 = lg[0];
#pragma unroll
        for (int e = 1; e < 8; ++e) if (lg[e] > v1) { v1 = lg[e]; e1 = e; }
        int e2 = -1; float v2 = -__builtin_inff();
#pragma unroll
        for (int e = 0; e < 8; ++e) if (e != e1 && lg[e] > v2) { v2 = lg[e]; e2 = e; }
        unsigned p1 = 0u, p2 = 0u;
        if (lane == 0) { p1 = __hip_atomic_fetch_add(cnt + e1, 1u, RLX_AGENT); p2 = __hip_atomic_fetch_add(cnt + e2, 1u, RLX_AGENT); }
        unsigned pk[8];
#pragma unroll
        for (int j = 0; j < 8; ++j) pk[j] = pk4_fp8(v[j].x * F8_SA, v[j].y * F8_SA, v[j].z * F8_SA, v[j].w * F8_SA);
        const int row1 = e1 * ECAP + __builtin_amdgcn_readfirstlane((int)p1), row2 = e2 * ECAP + __builtin_amdgcn_readfirstlane((int)p2);
        GAS unsigned* o1 = (GAS unsigned*)(XIN + (size_t)row1 * D) + lane; GAS unsigned* o2 = (GAS unsigned*)(XIN + (size_t)row2 * D) + lane;
#pragma unroll
        for (int j = 0; j < 8; ++j) { o1[64 * j] = pk[j]; o2[64 * j] = pk[j]; }
        if (lane == 0) { const float ex = __expf(v2 - v1);
            rowtok[row1] = 2 * t; roww[row1] = 1.0f / (1.0f + ex); rowtok[row2] = 2 * t + 1; roww[row2] = ex / (1.0f + ex); }
    }
    __syncthreads();
}
struct MoeTiles { int ts[9]; };
__device__ __forceinline__ void moe_counts(const Frame& F, int (&ts)[9]) {
    const GAS v4u* cnt = (const GAS v4u*)((gu32*)(F.ws + WS_CTL) + CW_CNT); int acc = 0;
    const v4u c0 = cnt[0], c1 = cnt[1];
#define MC_STEP(e, val) { ts[e] = acc; const unsigned cn = (unsigned)__builtin_amdgcn_readfirstlane((int)(val)); acc += (int)((cn + 255u) >> 8); }
    MC_STEP(0, c0.x) MC_STEP(1, c0.y) MC_STEP(2, c0.z) MC_STEP(3, c0.w) MC_STEP(4, c1.x) MC_STEP(5, c1.y) MC_STEP(6, c1.z) MC_STEP(7, c1.w)
#undef MC_STEP
    ts[8] = acc;
}
__device__ __forceinline__ void moe_tail_reduce(const Frame& F) {
    int ts[9]; moe_counts(F, ts);
    const int total = ts[8] * 8, first = total & ~255, R = total - first, S = tail_slices(R);
    if (S == 1 || F.G != 256) return;
    MoeOrder M{F.G, 0, 8, ts[8], ts[1], ts[2], ts[3], ts[4], ts[5], ts[6], ts[7], 0};
    const float* PART = (const float*)(F.ws + WS_XIN);
    const int* rowtok = (const int*)(F.ws + WS_ROWTOK); const float* roww = (const float*)(F.ws + WS_ROWW); bf16* Y = (bf16*)(F.ws + WS_XB);
    for (int it = F.vcu * NTHR + F.tid; it < R * 16384; it += F.G * NTHR) {
        const int u = it >> 14, e = it & 16383, r = e >> 6, c4 = (e & 63) * 4;
        pg8::Unit un; M.unit_of(first + u, un);
        const GAS f32x4* p = (const GAS f32x4*)(PART + (size_t)(u * S) * 65536 + (size_t)r * 256 + c4);
        const int row = un.aux * 256 + r, tk = rowtok[row]; const float rw_ = roww[row];
        f32x4 a = p[0];
        { f32x4 q[13];
#pragma unroll
            for (int s = 1; s < 14; ++s) q[s - 1] = (s < S) ? p[(size_t)s * 16384] : (f32x4){0.f, 0.f, 0.f, 0.f};
#pragma unroll
            for (int s = 1; s < 14; ++s) if (s < S) a = a + q[s - 1]; }
        if (tk >= 0) { const float w = rw_ * (1.0f / (F8_SACT * F8_SW)); v2u o; o.x = pk2(a.x * w, a.y * w); o.y = pk2(a.z * w, a.w * w);
            *(GAS v2u*)(Y + (size_t)tk * 2048 + (un.pn & 7) * 256 + c4) = o; }
    }
}
template <bool X16> __device__ __forceinline__ void final_phase(const Frame& F, const float* gfin, float* out) {
    const int gw = F.vcu * NWAVES + F.wave, NGW = F.G * NWAVES, lane = F.lane;
    const float* XA = (const float*)(F.ws + WS_XA); const bf16* Y = (const bf16*)(F.ws + WS_XB);
    for (int t = gw; t < NTOK; t += NGW) {
        const GAS v2u* y0 = (const GAS v2u*)(Y + (size_t)(2 * t) * D) + lane; const GAS v2u* y1 = (const GAS v2u*)(Y + (size_t)(2 * t + 1) * D) + lane;
        f32x4 v[8]; float s = 0.f;
#pragma unroll
        for (int j = 0; j < 8; ++j) { const v2u a = y0[64 * j], bq = y1[64 * j];
            f32x4 xv; if constexpr (X16) { const v2u w = ((const GAS v2u*)((const bf16*)(const void*)XA + (size_t)t * D) + lane)[64 * j]; xv = (f32x4){bflo(w.x), bfhi(w.x), bflo(w.y), bfhi(w.y)}; } else xv = ((const GAS f32x4*)(XA + (size_t)t * D) + lane)[64 * j];
            v[j] = xv + (f32x4){bflo(a.x), bfhi(a.x), bflo(a.y), bfhi(a.y)} + (f32x4){bflo(bq.x), bfhi(bq.x), bflo(bq.y), bfhi(bq.y)};
            s += (v[j].x * v[j].x + v[j].y * v[j].y) + (v[j].z * v[j].z + v[j].w * v[j].w); }
        const float rstd = 1.0f / sqrtf(wave_sum(s) * (1.f / D) + RMS_EPS);
        const GAS f32x4* gr = (const GAS f32x4*)gfin + lane; GAS f32x4* o = (GAS f32x4*)(out + (size_t)t * D) + lane;
#pragma unroll
        for (int j = 0; j < 8; ++j) o[64 * j] = v[j] * rstd * gr[64 * j];
    }
}

constexpr int NPHASE = 23;
__global__ void __launch_bounds__(NTHR, 2) fwd_kernel(Args args) {
    extern __shared__ __attribute__((aligned(16))) unsigned char lds_raw[];
    Frame F;
    F.lds = (LAS unsigned char*)lds_raw; F.ws = args.ws;
    F.tid = threadIdx.x; F.lane = F.tid & 63; F.wave = __builtin_amdgcn_readfirstlane(F.tid >> 6);
    F.G = gridDim.x; { const int bx = blockIdx.x; F.vcu = (F.G % 8 == 0) ? (bx % 8) * (F.G / 8) + bx / 8 : bx; }
    volatile LAS unsigned* MISC = (volatile LAS unsigned*)(F.lds + MISC_OFF);
    for (int u = F.tid; u < (LDS_BYTES - RING_BYTES) / 4; u += NTHR) ((LAS unsigned*)(F.lds + RING_BYTES))[u] = 0u;
    __syncthreads();
    XcdBarrier bar; bar.bar = (unsigned*)(args.ws + WS_CTL) + CW_BAR; bar.x = 0; bar.st = nullptr;
    if (!MK_PER_PHASE) bar = xcd_barrier_post((unsigned*)(args.ws + WS_CTL) + CW_BAR, MISC + 8);
    if (!MK_PER_PHASE && F.tid == 0) __hip_atomic_store((unsigned*)(args.ws + WS_CTL) + CW_XID + blockIdx.x, bar.x + 1u, __ATOMIC_RELAXED, __HIP_MEMORY_SCOPE_AGENT);
    const int lo = args.ph_lo, hi = args.ph_hi;
#ifndef KMASK
#define KMASK 0xFFFFFFFFu
#endif
#define KEN(kind) (((KMASK) >> (kind)) & 1u)
#ifndef DUPMASK
#define DUPMASK 0u
#endif
#define DUP(kind) (((DUPMASK) >> (kind)) & 1u)
#define PHASE(kind, k, ...) do { if (KEN(kind) && IN(k)) { __VA_ARGS__ } if (DUP(kind) && KEN(kind) && IN(k)) { __VA_ARGS__ } } while (0)
#define IN(k) (lo <= (k) && (k) < hi)
#define SEAM(k) do { if (IN(k) && IN((k) + 1)) xcd_barrier(bar); } while (0)
#define BSEAM(k, idx) do { if (IN(k) && IN((k) + 1)) { if (!MK_PER_PHASE && FUSE_RMS && F8_FFN && F.G == 256) batch_barrier((unsigned*)(args.ws + WS_CTL), (int)blockIdx.x, 32u * (unsigned)(idx), MISC + 11); else xcd_barrier(bar); } } while (0)
#define GSEAM(k, idx) do { if (IN(k) && IN((k) + 1)) { if (!MK_PER_PHASE && FUSE_RMS && F8_FFN && F.G == 256) group_barrier((unsigned*)(args.ws + WS_CTL), (int)blockIdx.x, 4u * (unsigned)(idx), MISC + 10); else xcd_barrier(bar); } } while (0)
#define PHASE_BEGIN() const CAS Args* ap = (const CAS Args*)__builtin_amdgcn_kernarg_segment_ptr(); asm volatile("" : "+s"(ap)); Frame Fp = fresh(F); Fp.ws = ap->ws; unsigned char* const ws = Fp.ws; LAS unsigned char* const ring = Fp.lds; const int cB = (int)blockIdx.x; (void)ws; (void)ring; (void)cB

    PHASE(0, 0, PHASE_BEGIN(); prologue(Fp, ap);); SEAM(0);

    for (int L = 0; L < 2; ++L) {
        const int P = 1 + 10 * L;
        PHASE(1, P + 0, PHASE_BEGIN();
            const int hA0 = L == 0 ? NPT : 0, wB0 = L == 0 ? 0 : 64;
            const bf16* base = (const bf16*)(ws + (L == 0 ? WS_W0 : WS_H));
            const int nconv = (L == 0 && Fp.G == 256) ? NCONV : 0, Gg = Fp.G - nconv;
            if (cB < Gg) {
                const bool fused = FUSE_RMS && L == 1 && Fp.G == 256; if (fused) rstd_table(Fp, (const float*)(ws + WS_SLAB) + (size_t)32 * NTOK, fixed_panel(cB));
                pg8::Gemm g{base, base, 0, 0, D}; ProjOrder S{Gg, cB, hA0, wB0}; EpiProj E{ws, hA0, wB0, fused ? (const LAS float*)(Fp.lds + RSTD_OFF) : nullptr};
                pg8::gemm_phase<EpiProj, ProjOrder, true, true>(ring, g, S, E);
            } else { convert_expert_blocks(Fp, ap, cB - Gg, nconv, 0, XB_TOTAL); convert_items(Fp, ap, (cB - Gg) * NWAVES + Fp.wave, nconv * NWAVES, I_IN, CB1); }
        ); if (L == 0) SEAM(P + 0); else BSEAM(P + 0, 3);
        PHASE(2, P + 1, PHASE_BEGIN(); const int nconv = 0, Gg = Fp.G - nconv;
            if (cB < Gg) indexer_phase(Fp, nconv > 0, (gu32*)(ws + WS_CTL) + CW_QI, Fp.G == 256 ? cB : Fp.vcu); else convert_expert_items(Fp, ap, (cB - Gg) * NWAVES + Fp.wave, nconv * NWAVES, CBS1, CBS2););
        PHASE(15, P + 1, PHASE_BEGIN(); const int nconv = 0, Gg = Fp.G - nconv;
            if (nconv == 0) conv_phase(Fp, ap->in[3] + (size_t)L * 3 * 1024, Fp.vcu, Fp.G); else if (cB < Gg) conv_phase(Fp, ap->in[3] + (size_t)L * 3 * 1024, cB, Gg);); BSEAM(P + 1, L == 0 ? 1 : 4);
        PHASE(3, P + 2, PHASE_BEGIN(); const int nconv = 0, Gg = Fp.G - nconv;
            if (cB < Gg) attn_phase(Fp, nconv > 0, (gu32*)(ws + WS_CTL) + CW_QA, Fp.G == 256 ? cB : Fp.vcu); else convert_expert_items(Fp, ap, (cB - Gg) * NWAVES + Fp.wave, nconv * NWAVES, CBS2, CB10);
            __syncthreads();); BSEAM(P + 2, L == 0 ? 2 : 5);
        PHASE(4, P + 3, PHASE_BEGIN();
            pg8::Gemm g{(const bf16*)(ws + WS_YMIX), (const bf16*)(ws + WS_WC) + (size_t)L * D * D, 0, 0, D}; PlainOrder S{64, 8, Fp.G, cB, 0, 0}; EpiMix E{ws};
            pg8::gemm_phase<EpiMix, PlainOrder, true, true>(ring, g, S, E);
        ); GSEAM(P + 3, L == 0 ? 1 : 5);
        PHASE(6, P + 5, PHASE_BEGIN();
            const bool fz = FUSE_RMS && F8_FFN && Fp.G == 256;
            pg8::Gemm g{(const bf16*)(ws + WS_Z), (const bf16*)(ws + WS_WO) + (size_t)L * D * D, 0, 0, D}; PlainOrder S{64, 8, Fp.G, cB, 0, 0};
            if (fz && L == 0) { EpiRes2<true, true, true> E{(const void*)(ws + WS_H), (void*)(ws + WS_XA), 1.0f, ap->in[7], (void*)(ws + WS_XB), (float*)(ws + WS_SLAB), ap->in[1], (const float*)(ws + WS_RMS0)};
                pg8::gemm_phase<EpiRes2<true, true, true>, PlainOrder, true, true>(ring, g, S, E); }
            else if (fz) { EpiRes<true, true> E{(const void*)(ws + WS_H), (void*)(ws + WS_XA), 1.0f, ap->in[1] + D};
                pg8::gemm_phase<EpiRes<true, true>, PlainOrder, true, true>(ring, g, S, E); }
            else { EpiRes<false, false> E{L == 0 ? (const void*)ap->in[0] : (const void*)(ws + WS_XB), (void*)(ws + WS_XA), 1.0f, nullptr};
                pg8::gemm_phase<EpiRes<false, false>, PlainOrder, true, true>(ring, g, S, E); }
        ); if (L == 0) GSEAM(P + 5, 2); else SEAM(P + 5);
        PHASE(7, P + 6, PHASE_BEGIN();
            if (L == 0 && FUSE_RMS && F8_FFN && Fp.G == 256) {   }
            else if (L == 0) { if (F8_FFN) rms_pass_f8(Fp, (const float*)(ws + WS_XA), ap->in[7], (unsigned char*)(ws + WS_H)); else rms_pass(Fp, (const float*)(ws + WS_XA), ap->in[7], (bf16*)(ws + WS_H)); }
            else if (FUSE_RMS && F8_FFN && Fp.G == 256) router_phase<true>(Fp, (const void*)(ws + WS_XA), ap->in[7] + D, ap->in[11]); else router_phase<false>(Fp, (const void*)(ws + WS_XA), ap->in[7] + D, ap->in[11]);
        ); if (!(L == 0 && FUSE_RMS && F8_FFN && F.G == 256)) SEAM(P + 6);
        if (L == 0) {
            PHASE(8, P + 7, PHASE_BEGIN();
                if constexpr (F8_FFN) { const bool fused = FUSE_RMS && Fp.G == 256; pg8::Gemm g{(const bf16*)(ws + (fused ? WS_XB : WS_H)), (const bf16*)(ws + WS_W13), 0, 0, D / 2}; PlainOrder S{64, 44, Fp.G, cB, 0, 0}; if (fused) rstd_table(Fp, (const float*)(ws + WS_SLAB), fixed_panel(cB));
                    EpiSwigluF8 E{(unsigned char*)(ws + WS_ACT), FF, 44, fused ? (const LAS float*)(Fp.lds + RSTD_OFF) : nullptr, 0};
                    pg8::gemm_phase<EpiSwigluF8, PlainOrder, true, true, true>(ring, g, S, E); }
                else { pg8::Gemm g{(const bf16*)(ws + WS_H), (const bf16*)(ws + WS_W13), 0, 0, D}; PlainOrder S{64, 44, Fp.G, cB, 0, 0}; EpiSwiglu E{(bf16*)(ws + WS_ACT), FF, 44};
                    pg8::gemm_phase<EpiSwiglu, PlainOrder, true, true>(ring, g, S, E); }
            ); GSEAM(P + 7, 3);
            PHASE(9, P + 8, PHASE_BEGIN();
                if constexpr (F8_FFN) { pg8::Gemm g{(const bf16*)(ws + WS_ACT), (const bf16*)(ws + WS_W2), 0, 0, FF / 2}; PlainOrder S{64, 8, Fp.G, cB, 0, 0}; if (FUSE_RMS && Fp.G == 256) { EpiRes2<false, true, true> E{(const void*)(ws + WS_XA), nullptr, 1.0f / (F8_SACT * F8_SW), ap->in[1] + D, (void*)(ws + WS_H), (float*)(ws + WS_SLAB) + (size_t)32 * NTOK, nullptr, nullptr};
                        pg8::gemm_phase<EpiRes2<false, true, true>, PlainOrder, true, true, true>(ring, g, S, E); }
                    else { EpiRes<false, false> E{(const void*)(ws + WS_XA), (void*)(ws + WS_XB), 1.0f / (F8_SACT * F8_SW), nullptr};
                        pg8::gemm_phase<EpiRes<false, false>, PlainOrder, true, true, true>(ring, g, S, E); } }
                else { pg8::Gemm g{(const bf16*)(ws + WS_ACT), (const bf16*)(ws + WS_W2), 0, 0, FF}; PlainOrder S{64, 8, Fp.G, cB, 0, 0}; EpiRes<false, false> E{(const void*)(ws + WS_XA), (void*)(ws + WS_XB), 1.0f, nullptr};
                    pg8::gemm_phase<EpiRes<false, false>, PlainOrder, true, true>(ring, g, S, E); }
            ); GSEAM(P + 8, 4);
            PHASE(10, P + 9, PHASE_BEGIN(); if (!(FUSE_RMS && F8_FFN && Fp.G == 256)) rms_pass(Fp, (const float*)(ws + WS_XB), ap->in[1] + D, (bf16*)(ws + WS_H));); if (!(FUSE_RMS && F8_FFN && F.G == 256)) SEAM(P + 9);
        } else {
            PHASE(12, P + 8, PHASE_BEGIN();
                int ts[9]; moe_counts(Fp, ts);
                pg8::Gemm g{(const bf16*)(ws + WS_XIN), (const bf16*)(ws + WS_EW13), 0, 0, D / 2};
                MoeOrder S{Fp.G, cB, 56, ts[8], ts[1], ts[2], ts[3], ts[4], ts[5], ts[6], ts[7], 1}; EpiSwigluF8 E{(unsigned char*)(ws + WS_EACT), FFE, 56, nullptr, 1};
                pg8::gemm_phase<EpiSwigluF8, MoeOrder, true, true, true>(ring, g, S, E);
            ); SEAM(P + 8);
            PHASE(13, P + 9, PHASE_BEGIN();
                int ts[9]; moe_counts(Fp, ts);
                const int total = ts[8] * 8, first = total & ~255, R = total - first, S = (Fp.G == 256) ? tail_slices(R) : 1;
                MoeOrder S0{Fp.G, cB, 8, ts[8], ts[1], ts[2], ts[3], ts[4], ts[5], ts[6], ts[7], 0}; if (S > 1) S0.limit = first;
                { pg8::Gemm g{(const bf16*)(ws + WS_EACT), (const bf16*)(ws + WS_EW2), 0, 0, FFE / 2}; EpiMoeDown E{ws};
                  pg8::gemm_phase<EpiMoeDown, MoeOrder, true, true, true>(ring, g, S0, E); }
                if (S > 1) { pg8::Gemm g{(const bf16*)(ws + WS_EACT), (const bf16*)(ws + WS_EW2), 0, 0, FFE / 2, (FFE / 2) / S}; MoeTailOrder S1{S0, first, R, S}; EpiPartial E{(float*)(ws + WS_XIN) + (size_t)cB * 65536};
                  pg8::gemm_phase<EpiPartial, MoeTailOrder, true, true, true>(ring, g, S1, E); }
            ); SEAM(P + 9);
        }
    }
    PHASE(16, 21, PHASE_BEGIN(); moe_tail_reduce(Fp);); SEAM(21);
    PHASE(14, 22, PHASE_BEGIN(); if (FUSE_RMS && F8_FFN && Fp.G == 256) final_phase<true>(Fp, ap->in[15], ap->out); else final_phase<false>(Fp, ap->in[15], ap->out););
#undef IN
#undef SEAM
}

extern "C" void kernel_launch(void* const* d_in, const int* in_sizes, int n_in, void* d_out, int out_size, void* d_ws, size_t ws_size, hipStream_t stream) {
    static int grid = 0;
    if (grid == 0) {
        if (n_in != 16 || out_size != NTOK * D || ws_size < WS_END) { fprintf(stderr, "kernel_launch: unexpected shapes (n_in %d, out %d, ws %zu < %zu)\n", n_in, out_size, ws_size, (size_t)WS_END); grid = -1; return; }
        int dev = 0, cus = 0, per_cu = 0;
        if (hipGetDevice(&dev) != hipSuccess || hipDeviceGetAttribute(&cus, hipDeviceAttributeMultiprocessorCount, dev) != hipSuccess) { grid = -1; return; }
        if (hipFuncSetAttribute((const void*)fwd_kernel, hipFuncAttributeMaxDynamicSharedMemorySize, LDS_BYTES) != hipSuccess) { fprintf(stderr, "kernel_launch: hipFuncSetAttribute failed\n"); grid = -1; return; }
        if (hipOccupancyMaxActiveBlocksPerMultiprocessor(&per_cu, (const void*)fwd_kernel, NTHR, LDS_BYTES) != hipSuccess || per_cu < 1) fprintf(stderr, "kernel_launch: occupancy query says %d\n", per_cu);
        (void)hipGetLastError();
        grid = cus;
    }
    if (grid < 0) return;
    (void)hipMemsetAsync((char*)d_ws + WS_CTL, 0, CTL_ZERO_BYTES, stream);
    Args a{};
    for (int i = 0; i < 16; ++i) a.in[i] = (const float*)d_in[i];
    a.out = (float*)d_out; a.ws = (unsigned char*)d_ws;
#if MK_PER_PHASE
    for (int p = 0; p < NPHASE; ++p) { a.ph_lo = p; a.ph_hi = p + 1; hipLaunchKernelGGL(fwd_kernel, dim3(grid), dim3(NTHR), LDS_BYTES, stream, a); }
#else
    a.ph_lo = 0; a.ph_hi = NPHASE;
    hipLaunchKernelGGL(fwd_kernel, dim3(grid), dim3(NTHR), LDS_BYTES, stream, a);
#endif
}
```
